# Optimizing an MI355X kernel written in HIP

```python
import jax, jax.numpy as jnp
from jax import lax
import numpy as np

D_MODEL = 1024
BATCH = 8
SEQ = 4096
DEPTH = 1

CTX_LEN = 256
GRID_W = 64
D_MIX = D_MODEL
D_GMLP = D_MIX // 2
G_A = 4
GA_DIM = D_GMLP // G_A
CHUNK_A = 2 * GRID_W
D_MLSTM = D_MIX - D_GMLP
H_B = 4
HV = D_MLSTM // H_B
HK = HV // 2
D_QK = H_B * HK
CONV_W = 3
CHUNK_B = 128
N_GATES = 4 * H_B
D_IN = 2 * D_GMLP + 2 * D_QK + 2 * D_MLSTM + N_GATES
D_FF = 4 * D_MODEL
ALPHA = (2 * DEPTH) ** 0.25
BETA = (8 * DEPTH) ** -0.25
LN_EPS = 1e-5

kernel_name = "hymba_style_gmlp_mlstm_dit_layer"


def _ln_stats(x):
    xf = x.astype(jnp.float32)
    mu = jnp.mean(xf, axis=-1, keepdims=True)
    var = jnp.mean(jnp.square(xf - mu), axis=-1, keepdims=True)
    return (xf - mu) * lax.rsqrt(var + LN_EPS)


def layer_norm(x, g, b):
    return (_ln_stats(x) * g + b).astype(x.dtype)


def modulate(x, shift, scale):
    return _ln_stats(x).astype(x.dtype) * (1 + scale) + shift


def ada_split(cond, w_ada, b_ada):
    return jnp.split(jax.nn.silu(cond) @ w_ada + b_ada, 6, axis=-1)


def split_proj(p):
    bounds = [D_GMLP, 2 * D_GMLP, 2 * D_GMLP + D_QK, 2 * D_GMLP + 2 * D_QK,
              2 * D_GMLP + 2 * D_QK + D_MLSTM, 2 * D_GMLP + 2 * D_QK + 2 * D_MLSTM]
    return jnp.split(p, bounds, axis=-1)


def spatial_gating(u, v, w_s, b_s, g_v, b_v):
    bsz, s, _ = v.shape
    vc = layer_norm(v, g_v, b_v).reshape(bsz, s // CHUNK_A, CHUNK_A, G_A, GA_DIM)
    mixed = jnp.einsum('gts,bnsgd->bntgd', w_s, vc) + b_s.T[:, :, None]
    return u * mixed.reshape(bsz, s, D_GMLP)


def short_conv(x, w):
    pad = CONV_W // 2
    return lax.conv_general_dilated(
        x, w[:, None, :], window_strides=(1,), padding=[(pad, pad)],
        dimension_numbers=('NWC', 'WIO', 'NWC'), feature_group_count=x.shape[-1])


def mlstm_inputs(q, k, vv, gates, conv_w, b_gates):
    bsz, s, _ = q.shape
    qk = jax.nn.silu(short_conv(jnp.concatenate([q, k], axis=-1), conv_w))
    q, k = jnp.split(qk, 2, axis=-1)
    heads = lambda a, d: a.reshape(bsz, s, H_B, d).transpose(0, 2, 1, 3)
    g = (gates + b_gates).reshape(bsz, s, 4, H_B).transpose(2, 0, 3, 1)
    return heads(q, HK), heads(k, HK), heads(vv, HV), g


def mlstm_chunkwise(q, k, v, ig, fg, state):
    bsz, nh, s, _ = q.shape
    nc = s // CHUNK_B
    f32 = jnp.float32
    q = q.astype(f32) * (HK ** -0.5)
    k = k.astype(f32)
    v = v.astype(f32)
    ig = ig.astype(f32)
    logf = jax.nn.log_sigmoid(fg.astype(f32))

    def to_chunks(a):
        return jnp.moveaxis(a.reshape(bsz, nh, nc, CHUNK_B, *a.shape[3:]), 2, 0)

    tri = jnp.tril(jnp.ones((CHUNK_B, CHUNK_B), dtype=bool))

    def step(carry, xs_c):
        c0, n0, m0 = carry
        qc, kc, vc, ic, lfc = xs_c
        b = jnp.cumsum(lfc, axis=-1)
        dmat = jnp.where(tri, b[..., :, None] - b[..., None, :] + ic[..., None, :], -jnp.inf)
        inter = b + m0[..., None]
        m = jnp.maximum(inter, jnp.max(dmat, axis=-1))
        w_intra = jnp.exp(dmat - m[..., None])
        w_inter = jnp.exp(inter - m)
        scores = jnp.einsum('bhtk,bhsk->bhts', qc, kc) * w_intra
        num = (jnp.einsum('bhts,bhsv->bhtv', scores, vc)
               + w_inter[..., None] * jnp.einsum('bhtk,bhkv->bhtv', qc, c0))
        den = jnp.sum(scores, axis=-1) + w_inter * jnp.einsum('bhtk,bhk->bht', qc, n0)
        h = num / jnp.maximum(jnp.abs(den), jnp.exp(-m))[..., None]
        b_last = b[..., -1]
        dec = b_last[..., None] - b + ic
        m_new = jnp.maximum(b_last + m0, jnp.max(dec, axis=-1))
        w_s = jnp.exp(dec - m_new[..., None])
        carry_w = jnp.exp(b_last + m0 - m_new)
        c_new = carry_w[..., None, None] * c0 + jnp.einsum('bhs,bhsk,bhsv->bhkv', w_s, kc, vc)
        n_new = carry_w[..., None] * n0 + jnp.einsum('bhs,bhsk->bhk', w_s, kc)
        return (c_new, n_new, m_new), h

    xs = (to_chunks(q), to_chunks(k), to_chunks(v), to_chunks(ig), to_chunks(logf))
    state, hs = lax.scan(step, state, xs)
    h = jnp.moveaxis(hs, 0, 2).reshape(bsz, nh, s, HV)
    return h, state


def mlstm_bidirectional(ctx_in, lat_in):
    qc, kc, vc, gc = ctx_in
    ql, kl, vl, gl = lat_in
    bsz = ql.shape[0]
    f32 = jnp.float32
    zero = (jnp.zeros((bsz, H_B, HK, HV), f32), jnp.zeros((bsz, H_B, HK), f32), jnp.zeros((bsz, H_B), f32))
    flip = lambda a: jnp.flip(a, axis=2)
    hc_f, st_f = mlstm_chunkwise(qc, kc, vc, gc[0], gc[1], zero)
    hl_f, _ = mlstm_chunkwise(ql, kl, vl, gl[0], gl[1], st_f)
    hc_b, st_b = mlstm_chunkwise(flip(qc), flip(kc), flip(vc), flip(gc[2]), flip(gc[3]), zero)
    hl_b, _ = mlstm_chunkwise(flip(ql), flip(kl), flip(vl), flip(gl[2]), flip(gl[3]), st_b)
    return hc_f + flip(hc_b), hl_f + flip(hl_b)


def head_norm(h, g):
    bsz, nh, s, dv = h.shape
    y = _ln_stats(h).transpose(0, 2, 1, 3).reshape(bsz, s, nh * dv)
    return y * g


def mixer_output(u, v, h_b, o, w_s, b_s, ln_v_g, ln_v_b, hn_g, w_out):
    y_a = spatial_gating(u, v, w_s, b_s, ln_v_g, ln_v_b)
    y_b = head_norm(h_b, hn_g).astype(o.dtype) * jax.nn.sigmoid(o)
    return jnp.concatenate([y_a, y_b], axis=-1) @ w_out


def channel_mlp(h, w1, b1, w2, b2):
    return jnp.square(jax.nn.relu(h @ w1 + b1)) @ w2 + b2


def deepnorm_update(x, y, gate, g, b):
    return layer_norm(ALPHA * x + gate * y, g, b)


def setup_inputs(seed: int = 0) -> dict:
    key = jax.random.key(seed)
    ks = jax.random.split(key, 28)
    nrm = lambda k, shape, s: jax.random.normal(k, shape, jnp.float32) * s
    L = DEPTH
    f_bias = jnp.linspace(3.0, 6.0, H_B, dtype=jnp.float32)
    b_gates = jnp.concatenate([
        nrm(ks[10], (L, H_B), 0.1), f_bias + nrm(ks[11], (L, H_B), 0.1),
        nrm(ks[12], (L, H_B), 0.1), f_bias + nrm(ks[13], (L, H_B), 0.1)], axis=-1)
    return {
        "x": nrm(ks[0], (BATCH, SEQ, D_MODEL), 1.0),
        "c": nrm(ks[1], (BATCH, D_MODEL), 1.0),
        "ctx": nrm(ks[2], (BATCH, CTX_LEN, D_MODEL), 1.0),
        "c_ctx": nrm(ks[3], (D_MODEL,), 1.0),
        "w_ada": nrm(ks[4], (L, D_MODEL, 6 * D_MODEL), D_MODEL ** -0.5),
        "b_ada": nrm(ks[5], (L, 6 * D_MODEL), 0.01),
        "w_in": nrm(ks[6], (L, D_MODEL, D_IN), D_MODEL ** -0.5),
        "w_s": nrm(ks[7], (L, G_A, CHUNK_A, CHUNK_A), CHUNK_A ** -0.5),
        "b_s": 1.0 + nrm(ks[8], (L, G_A, CHUNK_A), 0.01),
        "ln_v_g": 1.0 + nrm(ks[9], (L, D_GMLP), 0.01),
        "ln_v_b": nrm(ks[14], (L, D_GMLP), 0.01),
        "conv_qk": nrm(ks[15], (L, CONV_W, 2 * D_QK), CONV_W ** -0.5),
        "b_gates": b_gates,
        "hn_g": 1.0 + nrm(ks[16], (L, D_MLSTM), 0.01),
        "w_out": nrm(ks[17], (L, D_MIX, D_MODEL), BETA * D_MIX ** -0.5),
        "ln1_g": 1.0 + nrm(ks[18], (L, D_MODEL), 0.01),
        "ln1_b": nrm(ks[19], (L, D_MODEL), 0.01),
        "w1": nrm(ks[20], (L, D_MODEL, D_FF), D_MODEL ** -0.5),
        "b1": nrm(ks[21], (L, D_FF), 0.01),
        "w2": nrm(ks[22], (L, D_FF, D_MODEL), BETA * D_FF ** -0.5),
        "b2": nrm(ks[23], (L, D_MODEL), 0.01),
        "ln2_g": 1.0 + nrm(ks[24], (L, D_MODEL), 0.01),
        "ln2_b": nrm(ks[25], (L, D_MODEL), 0.01),
    }


def reference(x, c, ctx, c_ctx, w_ada, b_ada, w_in, w_s, b_s, ln_v_g, ln_v_b, conv_qk, b_gates, hn_g,
              w_out, ln1_g, ln1_b, w1, b1, w2, b2, ln2_g, ln2_b):
    xc = ctx
    for l in range(DEPTH):
        sh1, sc1, g1, sh2, sc2, g2 = [m[:, None, :] for m in ada_split(c, w_ada[l], b_ada[l])]
        csh1, csc1, cg1, csh2, csc2, cg2 = ada_split(c_ctx, w_ada[l], b_ada[l])

        u_l, v_l, q_l, k_l, vv_l, o_l, gt_l = split_proj(modulate(x, sh1, sc1) @ w_in[l])
        u_c, v_c, q_c, k_c, vv_c, o_c, gt_c = split_proj(modulate(xc, csh1, csc1) @ w_in[l])

        hb_c, hb_l = mlstm_bidirectional(
            mlstm_inputs(q_c, k_c, vv_c, gt_c, conv_qk[l], b_gates[l]),
            mlstm_inputs(q_l, k_l, vv_l, gt_l, conv_qk[l], b_gates[l]))

        y_l = mixer_output(u_l, v_l, hb_l, o_l, w_s[l], b_s[l], ln_v_g[l], ln_v_b[l], hn_g[l], w_out[l])
        x_new = deepnorm_update(x, y_l, g1, ln1_g[l], ln1_b[l])
        x_new = deepnorm_update(x_new, channel_mlp(modulate(x_new, sh2, sc2), w1[l], b1[l], w2[l], b2[l]),
                                g2, ln2_g[l], ln2_b[l])

        if l < DEPTH - 1:
            y_c = mixer_output(u_c, v_c, hb_c, o_c, w_s[l], b_s[l], ln_v_g[l], ln_v_b[l], hn_g[l], w_out[l])
            xc = deepnorm_update(xc, y_c, cg1, ln1_g[l], ln1_b[l])
            xc = deepnorm_update(xc, channel_mlp(modulate(xc, csh2, csc2), w1[l], b1[l], w2[l], b2[l]),
                                 cg2, ln2_g[l], ln2_b[l])
        x = x_new
    return x
```

```cpp
#define N_LAUNCH_MODE 0
#include <hip/hip_runtime.h>
#include <hip/hip_cooperative_groups.h>
#include <cstdio>
namespace pg8 {
#define PG8_LAS __attribute__((address_space(3)))
typedef unsigned short bf16_t;
typedef short bf16x8 __attribute__((ext_vector_type(8)));
typedef float f32x4 __attribute__((ext_vector_type(4)));
typedef unsigned u32x4 __attribute__((ext_vector_type(4)));
constexpr int BM = 256, BK = 64, HALF = 128, HTB = HALF * BK * 2  , STAGE_BYTES = 8 * HTB, NXCD = 8, WGM = 8;

__host__ __device__ __forceinline__ int lds_byte(int r, int c) { const int st = (r >> 4) * 2 + (c >> 5), rr = r & 15, cc = c & 31, ob = rr * 64 + cc * 2; return st * 1024 + (ob ^ (((ob >> 9) & 1) << 5)); }
__host__ __device__ __forceinline__ void stage_rc(int b, int& R, int& C) { const int st = b / 1024, sb = b % 1024, swz = sb ^ (((sb >> 9) & 1) << 5); R = (st >> 1) * 16 + swz / 64; C = (st & 1) * 32 + (swz % 64) / 2; }
__host__ __device__ __forceinline__ int perm32(int rho) { const int n = rho >> 4, i = rho & 15; return 8 * (i >> 2) + 4 * n + (i & 3); }

struct Unit { int pm, pn; };
struct Gemm { const bf16_t* A; const bf16_t* Bt; int M, N, K; };

struct StaticOrder {
    int nM, nN, nwg, G, c;
    __host__ __device__ void init(int M, int N, int G_, int c_) { nM = M / BM; nN = N / BM; nwg = nM * nN; G = G_; c = c_; }
    __host__ __device__ bool next(int i, Unit& u) const {
        const long L = (long)i * G + c; if (L >= nwg) return false;
        int wgid = (int)L; { const int q = nwg / NXCD, r = nwg % NXCD, xcd = wgid % NXCD, off = wgid / NXCD; wgid = (xcd < r ? xcd * (q + 1) : r * (q + 1) + (xcd - r) * q) + off; }
        const int nig = WGM * nN, gid = wgid / nig, fm = gid * WGM, gsz = (nM - fm) < WGM ? (nM - fm) : WGM;
        u.pm = fm + ((wgid % nig) % gsz); u.pn = (wgid % nig) / gsz; return true;
    }
    __device__ __forceinline__ void a_ready(const Unit&) const {}
    __device__ __forceinline__ void done(const Unit&) const {}
};
__device__ __forceinline__ unsigned cvt_pk_bf16(float lo, float hi) { unsigned r; asm volatile("v_cvt_pk_bf16_f32 %0, %1, %2" : "=v"(r) : "v"(lo), "v"(hi)); return r; }
typedef float f32x2 __attribute__((ext_vector_type(2)));
__device__ __forceinline__ f32x2 gelu_pk(f32x2 v) {
    const f32x2 av = __builtin_elementwise_abs(v), d = av * 0.2316418882f + 1.0f;
    f32x2 t; t.x = __builtin_amdgcn_rcpf(d.x); t.y = __builtin_amdgcn_rcpf(d.y);
    f32x2 q = t * 0.5307027145f + (-0.7265760135f); q = q * t + 0.7107068705f; q = q * t + (-0.142248368f); q = q * t + 0.127414796f; q = q * t;
    const f32x2 s = (v * v) * (-0.72134752044f);
    f32x2 e; e.x = __builtin_amdgcn_exp2f(s.x); e.y = __builtin_amdgcn_exp2f(s.y);
    const f32x2 m = v * (q * e), r = v - m;
    f32x2 o; o.x = v.x < 0.f ? m.x : r.x; o.y = v.y < 0.f ? m.y : r.y; return o;
}

struct EpiF32 {
    static constexpr bool PERM = false, AFTER_DRAIN = false;
    float* C; int ldc; const float* bias;
    __device__ __forceinline__ void operator()(const f32x4 (&acc)[2][2][4][2], const Unit& u, int wr, int wc, int fr, int fq) const {
        const int row0 = u.pm * BM + wr * 64 + fr, col0 = u.pn * BM + wc * 32 + 4 * fq;
        f32x4 bv[2][2];
#pragma unroll
        for (int bj = 0; bj < 2; ++bj)
#pragma unroll
            for (int n = 0; n < 2; ++n) bv[bj][n] = bias ? *(const f32x4*)(bias + col0 + bj * HALF + n * 16) : (f32x4){0.f, 0.f, 0.f, 0.f};
#pragma unroll
        for (int ai = 0; ai < 2; ++ai)
#pragma unroll
            for (int m = 0; m < 4; ++m) { float* rowp = C + (size_t)(row0 + ai * HALF + m * 16) * ldc + col0;
#pragma unroll
                for (int bj = 0; bj < 2; ++bj)
#pragma unroll
                    for (int n = 0; n < 2; ++n) *(f32x4*)(rowp + bj * HALF + n * 16) = acc[ai][bj][m][n] + bv[bj][n]; }
    }
};
template <int ACT  > struct EpiBf16 {
    static constexpr bool PERM = true, AFTER_DRAIN = false;
    bf16_t* O; int ldc; const float* bias; int split_cols; size_t split_stride;
    __device__ __forceinline__ void operator()(const f32x4 (&acc)[2][2][4][2], const Unit& u, int wr, int wc, int fr, int fq) const {
        const int row0 = u.pm * BM + wr * 64 + fr; int colt = u.pn * BM; bf16_t* base = O;
        if (split_cols) { const int t = colt / split_cols; base += (size_t)t * split_stride; colt -= t * split_cols; }
        const int col0 = colt + wc * 32 + 8 * fq, bcol0 = u.pn * BM + wc * 32 + 8 * fq;
        f32x4 bv[2][2];
#pragma unroll
        for (int bj = 0; bj < 2; ++bj)
#pragma unroll
            for (int n = 0; n < 2; ++n) bv[bj][n] = bias ? *(const f32x4*)(bias + bcol0 + bj * HALF + 4 * n) : (f32x4){0.f, 0.f, 0.f, 0.f};
#pragma unroll
        for (int ai = 0; ai < 2; ++ai)
#pragma unroll
            for (int m = 0; m < 4; ++m) { bf16_t* rowp = base + (size_t)(row0 + ai * HALF + m * 16) * ldc + col0;
#pragma unroll
                for (int bj = 0; bj < 2; ++bj) { f32x4 v0 = acc[ai][bj][m][0] + bv[bj][0], v1 = acc[ai][bj][m][1] + bv[bj][1];
                    if (ACT == 1) { f32x2 a = gelu_pk((f32x2){v0[0], v0[1]}), b = gelu_pk((f32x2){v0[2], v0[3]}), c = gelu_pk((f32x2){v1[0], v1[1]}), d = gelu_pk((f32x2){v1[2], v1[3]});
                        v0 = (f32x4){a.x, a.y, b.x, b.y}; v1 = (f32x4){c.x, c.y, d.x, d.y}; }
                    if (ACT == 2) {
#pragma unroll
                        for (int j = 0; j < 4; ++j) { v0[j] = 0.5f * v0[j] * (1.0f + erff(v0[j] * 0.70710678f)); v1[j] = 0.5f * v1[j] * (1.0f + erff(v1[j] * 0.70710678f)); } }
                    if (ACT == 3) {
#pragma unroll
                        for (int j = 0; j < 4; ++j) { const float a0 = fmaxf(v0[j], 0.f), a1 = fmaxf(v1[j], 0.f); v0[j] = a0 * a0; v1[j] = a1 * a1; } }
                    u32x4 w; w.x = cvt_pk_bf16(v0[0], v0[1]); w.y = cvt_pk_bf16(v0[2], v0[3]); w.z = cvt_pk_bf16(v1[0], v1[1]); w.w = cvt_pk_bf16(v1[2], v1[3]);
                    *(u32x4*)(rowp + bj * HALF) = w; } }
    }
};
template <class Epi, class Sched, bool STAMP = false>
__device__ __forceinline__ void gemm_phase(PG8_LAS unsigned char* lds, const Gemm g, const Sched& S, const Epi& E, unsigned long long* stamps) {
    const int tid = threadIdx.x, wid = __builtin_amdgcn_readfirstlane(tid >> 6), lane = tid & 63, wr = wid >> 2, wc = wid & 3, fr = lane & 15, fq = lane >> 4;
    const int K = g.K, nt = K / BK;
    int ts_lo = 0, ts_hi = 0, nts = 0; const unsigned long long rt_entry = STAMP ? (unsigned long long)wall_clock64() : 0ull;
#define PG8_STAMP() do { if (STAMP && wid == 0 && nts < 64) { const unsigned long long _c = (unsigned long long)clock64(); \
        ts_lo = (lane == nts) ? (int)(unsigned)_c : ts_lo; ts_hi = (lane == nts) ? (int)(unsigned)(_c >> 32) : ts_hi; ++nts; } } while (0)
    PG8_STAMP();
    unsigned voffA[2], voffB[2];
#pragma unroll
    for (int i = 0; i < 2; ++i) { int R, C; stage_rc(tid * 16 + i * 8192, R, C); const int Rb = Epi::PERM ? ((R & ~31) + perm32(R & 31)) : R;
        voffA[i] = (unsigned)(R * K + C) * 2u; voffB[i] = (unsigned)(Rb * K + C) * 2u; }
    const size_t kstep = (size_t)(BK * 2);
    const size_t hstep = (size_t)HALF * K * 2;
    const size_t tstep = 2 * hstep;
    const unsigned ldsw = (unsigned)wid * 1024u;
    const int aoff = lds_byte(wr * 64 + fr, fq * 8), boff = lds_byte(wc * 32 + fr, fq * 8);
#define PG8_SA(b, h) (((b) * 2 + (h)) * HTB)
#define PG8_SB(b, h) ((4 + (b) * 2 + (h)) * HTB)
#define PG8_STAGE(bufoff, gbase, voff) do { _Pragma("unroll") for (int _i = 0; _i < 2; ++_i) \
        __builtin_amdgcn_global_load_lds((const unsigned*)((const char*)(gbase) + (voff)[_i]), (PG8_LAS unsigned*)(lds + (bufoff) + ldsw + _i * 8192), 16, 0, 0); } while (0)
#define PG8_LDA(dst, b, h) do { _Pragma("unroll") for (int m = 0; m < 4; ++m) _Pragma("unroll") for (int k = 0; k < 2; ++k) dst[m][k] = *(const PG8_LAS bf16x8*)(lds + PG8_SA(b, h) + aoff + m * 2048 + k * 1024); } while (0)
#define PG8_LDB(dst, b, h) do { _Pragma("unroll") for (int n = 0; n < 2; ++n) _Pragma("unroll") for (int k = 0; k < 2; ++k) dst[n][k] = *(const PG8_LAS bf16x8*)(lds + PG8_SB(b, h) + boff + n * 2048 + k * 1024); } while (0)
#define PG8_MMA(ai, bj, At, Bt) do { __builtin_amdgcn_s_setprio(1); _Pragma("unroll") for (int m = 0; m < 4; ++m) _Pragma("unroll") for (int n = 0; n < 2; ++n) _Pragma("unroll") for (int k = 0; k < 2; ++k) \
        acc[ai][bj][m][n] = __builtin_amdgcn_mfma_f32_16x16x32_bf16(Bt[n][k], At[m][k], acc[ai][bj][m][n], 0, 0, 0); __builtin_amdgcn_s_setprio(0); } while (0)
#define PG8_WAIT_V(n) asm volatile("s_waitcnt vmcnt(" #n ")" ::: "memory")
#define PG8_WAIT_L(n) asm volatile("s_waitcnt lgkmcnt(" #n ")" ::: "memory")
#define PG8_BAR __builtin_amdgcn_s_barrier()
#define PG8_SCHED __builtin_amdgcn_sched_barrier(0)
    Unit cur, nxt; int ui = 0;
    if (!S.next(0, cur)) return;
    f32x4 acc[2][2][4][2];
#pragma unroll
    for (int a = 0; a < 2; ++a)
#pragma unroll
        for (int b = 0; b < 2; ++b)
#pragma unroll
            for (int m = 0; m < 4; ++m)
#pragma unroll
                for (int n = 0; n < 2; ++n) acc[a][b][m][n] = (f32x4){0.f, 0.f, 0.f, 0.f};
    bf16x8 At[4][2], B0[2][2], B1[2][2];
    const char* cA = (const char*)g.A + (size_t)cur.pm * tstep; const char* cB = (const char*)g.Bt + (size_t)cur.pn * tstep;
    S.a_ready(cur);
    PG8_STAGE(PG8_SB(0, 0), cB, voffB); PG8_STAGE(PG8_SA(0, 0), cA, voffA); PG8_STAGE(PG8_SB(0, 1), cB + hstep, voffB); PG8_STAGE(PG8_SA(0, 1), cA + hstep, voffA);
    if (wr == 1) PG8_BAR;
    PG8_WAIT_V(4); PG8_BAR;
    PG8_STAGE(PG8_SB(1, 0), cB + kstep, voffB); PG8_STAGE(PG8_SA(1, 0), cA + kstep, voffA); PG8_STAGE(PG8_SB(1, 1), cB + hstep + kstep, voffB);
    PG8_WAIT_V(6); PG8_BAR;
    PG8_STAMP();
    for (;;) {
        const bool has_next = S.next(ui + 1, nxt);
        const char* nA = has_next ? (const char*)g.A + (size_t)nxt.pm * tstep : cA; const char* nB = has_next ? (const char*)g.Bt + (size_t)nxt.pn * tstep : cB;
        for (int t = 0; t < nt; t += 2) {
            const bool last = (t == nt - 2);
            const char* a1 = cA + (size_t)(t + 1) * kstep;
            const char* a2 = last ? nA : cA + (size_t)(t + 2) * kstep; const char* b2 = last ? nB : cB + (size_t)(t + 2) * kstep;
            const char* a3 = a2 + kstep; const char* b3 = b2 + kstep;
            if (last && has_next) S.a_ready(nxt);
            PG8_LDB(B0, 0, 0); PG8_SCHED; PG8_LDA(At, 0, 0); PG8_STAGE(PG8_SA(1, 1), a1 + hstep, voffA);
            PG8_WAIT_L(8); PG8_BAR; PG8_WAIT_L(0); PG8_MMA(0, 0, At, B0); PG8_BAR; PG8_SCHED;
            PG8_LDB(B1, 0, 1); PG8_STAGE(PG8_SB(0, 0), b2, voffB);
            PG8_BAR; PG8_WAIT_L(0); PG8_MMA(0, 1, At, B1); PG8_BAR;
            PG8_LDA(At, 0, 1); PG8_STAGE(PG8_SA(0, 0), a2, voffA);
            PG8_BAR; PG8_WAIT_L(0); PG8_MMA(1, 0, At, B0); PG8_BAR; PG8_SCHED;
            PG8_STAGE(PG8_SB(0, 1), b2 + hstep, voffB);
            PG8_WAIT_V(6); PG8_BAR; PG8_MMA(1, 1, At, B1); PG8_BAR;
            PG8_LDB(B0, 1, 0); PG8_SCHED; PG8_LDA(At, 1, 0); PG8_STAGE(PG8_SA(0, 1), a2 + hstep, voffA);
            PG8_WAIT_L(8); PG8_BAR; PG8_WAIT_L(0); PG8_MMA(0, 0, At, B0); PG8_BAR; PG8_SCHED;
            PG8_LDB(B1, 1, 1); PG8_STAGE(PG8_SB(1, 0), b3, voffB);
            PG8_BAR; PG8_WAIT_L(0); PG8_MMA(0, 1, At, B1); PG8_BAR;
            PG8_LDA(At, 1, 1); PG8_STAGE(PG8_SA(1, 0), a3, voffA);
            PG8_BAR; PG8_WAIT_L(0); PG8_MMA(1, 0, At, B0); PG8_BAR; PG8_SCHED;
            PG8_STAGE(PG8_SB(1, 1), b3 + hstep, voffB);
            PG8_WAIT_V(6); PG8_BAR; PG8_MMA(1, 1, At, B1); PG8_BAR;
        }
        PG8_STAMP();
        if constexpr (!Epi::AFTER_DRAIN) { E(acc, cur, wr, wc, fr, fq); S.done(cur); }
        PG8_STAMP();
        if (!has_next) break;
#pragma unroll
        for (int a = 0; a < 2; ++a)
#pragma unroll
            for (int b = 0; b < 2; ++b)
#pragma unroll
                for (int m = 0; m < 4; ++m)
#pragma unroll
                    for (int n = 0; n < 2; ++n) acc[a][b][m][n] = (f32x4){0.f, 0.f, 0.f, 0.f};
        cur = nxt; cA = nA; cB = nB; ++ui;
    }
    PG8_WAIT_V(0);
    if (wr == 0) PG8_BAR;
    PG8_BAR;
    if constexpr (Epi::AFTER_DRAIN) { E.fused(acc, cur, wr, wc, fr, fq, lds, wid, lane); S.done(cur); }
    PG8_STAMP();
    if (STAMP && wid == 0) { stamps[lane] = lane < nts ? (((unsigned long long)(unsigned)ts_hi << 32) | (unsigned)ts_lo) : 0ull;
        if (lane == 62) stamps[62] = rt_entry; if (lane == 63) stamps[63] = (unsigned long long)wall_clock64(); }
#undef PG8_STAMP
#undef PG8_SA
#undef PG8_SB
#undef PG8_STAGE
#undef PG8_LDA
#undef PG8_LDB
#undef PG8_MMA
#undef PG8_WAIT_V
#undef PG8_WAIT_L
#undef PG8_BAR
#undef PG8_SCHED
}
}

namespace cg = cooperative_groups;
#define LAS __attribute__((address_space(3)))
typedef unsigned short u16;
typedef short bf16x8 __attribute__((ext_vector_type(8)));
typedef float f32x4 __attribute__((ext_vector_type(4)));
typedef unsigned u32x4 __attribute__((ext_vector_type(4)));
typedef unsigned u32x2 __attribute__((ext_vector_type(2)));

constexpr int DM = 1024, NLAT = 32768, NCTX = 2048, MROWS = NLAT + NCTX, NP = 2560, DFF = 4096, NMOD = 6144;
constexpr int NCH = 34;
constexpr float ALPHA_F = 1.189207115002721f;
constexpr float LN_EPS_F = 1e-5f;
constexpr int LDS_BYTES = 144 * 1024;
constexpr int NTHREADS = 512;

constexpr size_t al256(size_t x) { return (x + 255) & ~(size_t)255; }
constexpr size_t WS_WIN = 0;
constexpr size_t WS_WG = WS_WIN + al256((size_t)NP * DM * 2);
constexpr size_t WS_WOUT = WS_WG + al256((size_t)16 * DM * 2);
constexpr size_t WS_W1 = WS_WOUT + al256((size_t)DM * DM * 2);
constexpr size_t WS_W2 = WS_W1 + al256((size_t)DFF * DM * 2);
constexpr size_t WS_WSB = WS_W2 + al256((size_t)DFF * DM * 2);
constexpr size_t WS_MOD = WS_WSB + al256((size_t)4 * 128 * 128 * 2);
constexpr size_t WS_GATES = WS_MOD + al256((size_t)9 * NMOD * 4);
constexpr size_t WS_GL = WS_GATES + al256((size_t)MROWS * 16 * 4);
constexpr size_t WS_ML = WS_GL + al256((size_t)64 * NCH * 4);
constexpr size_t WS_NU = WS_ML + al256((size_t)64 * NCH * 4);
constexpr size_t WS_NIN = WS_NU + al256((size_t)64 * NCH * 64 * 4);
constexpr size_t WS_MIN = WS_NIN + al256((size_t)64 * 32 * 64 * 4);
constexpr size_t WS_H = WS_MIN + al256((size_t)64 * 32 * 4);
constexpr size_t WS_YCAT = WS_H + al256((size_t)MROWS * DM * 2);
constexpr size_t WS_R1 = WS_YCAT + al256((size_t)NLAT * DM * 2);
constexpr size_t WS_P = WS_R1;
constexpr size_t WS_U = WS_P + al256((size_t)MROWS * NP * 2);
constexpr size_t WS_CIN = WS_U + al256((size_t)64 * NCH * 8192 * 4);
constexpr size_t WS_R1_END = WS_CIN + al256((size_t)64 * 32 * 8192 * 2);
constexpr size_t WS_A = WS_R1;
constexpr size_t WS_END = (WS_R1_END > WS_A + (size_t)NLAT * DFF * 2) ? WS_R1_END : WS_A + (size_t)NLAT * DFF * 2;

struct Params {
    const float *x, *c, *ctx, *c_ctx, *w_ada, *b_ada, *w_in, *w_s, *b_s, *ln_v_g, *ln_v_b, *conv_qk, *b_gates, *hn_g, *w_out, *ln1_g, *ln1_b, *w1, *b1, *w2, *b2, *ln2_g, *ln2_b;
    float* out; unsigned char* ws; int ph_lo, ph_hi;
};

__device__ __forceinline__ float bf2f(u16 b) { return __uint_as_float(((unsigned)b) << 16); }
__device__ __forceinline__ float bflo(unsigned w) { return __uint_as_float(w << 16); }
__device__ __forceinline__ float bfhi(unsigned w) { return __uint_as_float(w & 0xffff0000u); }
__device__ __forceinline__ unsigned pk2(float lo, float hi) { return pg8::cvt_pk_bf16(lo, hi); }
__device__ __forceinline__ u16 f2bf(float x) { return (u16)(pk2(x, 0.f) & 0xffffu); }
__device__ __forceinline__ float wsum(float v) {
#pragma unroll
    for (int o = 32; o >= 1; o >>= 1) v += __shfl_xor(v, o);
    return v; }
__device__ __forceinline__ float wmaxr(float v) {
#pragma unroll
    for (int o = 32; o >= 1; o >>= 1) v = fmaxf(v, __shfl_xor(v, o));
    return v; }
__device__ __forceinline__ float wscan_add(float x, int lane) {
#pragma unroll
    for (int o = 1; o < 64; o <<= 1) { const float y = __shfl_up(x, o); if (lane >= o) x += y; }
    return x; }
__device__ __forceinline__ float wscan_max(float x, int lane) {
#pragma unroll
    for (int o = 1; o < 64; o <<= 1) { const float y = __shfl_up(x, o); if (lane >= o) x = fmaxf(x, y); }
    return x; }
__device__ __forceinline__ float silu_f(float x) { return x / (1.0f + __expf(-x)); }
__device__ __forceinline__ float sigmoid_f(float x) { return 1.0f / (1.0f + __expf(-x)); }
__device__ __forceinline__ float logsigmoid_f(float x) { return fminf(x, 0.f) - log1pf(expf(-fabsf(x))); }

template <int NB, int KS>
__device__ __forceinline__ void wmma_lds(const LAS u16* A, int lda, const LAS u16* B, int ldb, f32x4 (&acc)[NB], int fr, int fq) {
#pragma unroll
    for (int kk = 0; kk < KS; ++kk) {
        const bf16x8 a = *(const LAS bf16x8*)(A + fr * lda + kk * 32 + fq * 8);
#pragma unroll
        for (int nb = 0; nb < NB; ++nb) {
            const bf16x8 b = *(const LAS bf16x8*)(B + (nb * 16 + fr) * ldb + kk * 32 + fq * 8);
            acc[nb] = __builtin_amdgcn_mfma_f32_16x16x32_bf16(a, b, acc[nb], 0, 0, 0);
        }
    }
}

__device__ __forceinline__ void transpose_tile(const float* src, int ldsrc, u16* dst, int K, int k0, int nsrc0, int ndst0, LAS float* tile, int tid) {
    {
        const int r = tid >> 4, c4 = (tid & 15) * 4;
#pragma unroll
        for (int hh = 0; hh < 2; ++hh) {
            const f32x4 v = *(const f32x4*)(src + (size_t)(k0 + r + hh * 32) * ldsrc + nsrc0 + c4);
            LAS float* t = tile + (r + hh * 32) * 65 + c4;
            t[0] = v[0]; t[1] = v[1]; t[2] = v[2]; t[3] = v[3];
        }
    }
    __syncthreads();
    {
        const int n = tid >> 3, k8 = (tid & 7) * 8;
        float v[8];
#pragma unroll
        for (int e = 0; e < 8; ++e) v[e] = tile[(k8 + e) * 65 + n];
        u32x4 w; w.x = pk2(v[0], v[1]); w.y = pk2(v[2], v[3]); w.z = pk2(v[4], v[5]); w.w = pk2(v[6], v[7]);
        *(u32x4*)(dst + (size_t)(ndst0 + n) * K + k0 + k8) = w;
    }
    __syncthreads();
}

__device__ __forceinline__ void phase_prep(const Params& p, LAS unsigned char* lds) {
    const int tid = threadIdx.x, G = gridDim.x, bx = blockIdx.x;
    unsigned char* ws = p.ws;
    {
        LAS float* cs = (LAS float*)lds;
        LAS float* red = (LAS float*)(lds + 9 * 1024 * 4);
        float* mod = (float*)(ws + WS_MOD);
        for (int u = bx; u < NMOD / 32; u += G) {
            for (int i = tid; i < 9 * 1024; i += NTHREADS) { const int r = i >> 10, k = i & 1023; const float v = (r < 8) ? p.c[r * 1024 + k] : p.c_ctx[k]; cs[i] = silu_f(v); }
            __syncthreads();
            const int kg = tid >> 5, col = tid & 31, n0 = u * 32;
            float acc[9];
#pragma unroll
            for (int r = 0; r < 9; ++r) acc[r] = 0.f;
#pragma unroll 4
            for (int k = kg; k < 1024; k += 16) {
                const float w = p.w_ada[(size_t)k * NMOD + n0 + col];
#pragma unroll
                for (int r = 0; r < 9; ++r) acc[r] += cs[r * 1024 + k] * w;
            }
#pragma unroll
            for (int r = 0; r < 9; ++r) red[(kg * 9 + r) * 32 + col] = acc[r];
            __syncthreads();
            if (tid < 288) {
                const int r = tid >> 5, cc = tid & 31; float s = 0.f;
#pragma unroll
                for (int g = 0; g < 16; ++g) s += red[(g * 9 + r) * 32 + cc];
                mod[r * NMOD + n0 + cc] = s + p.b_ada[n0 + cc];
            }
            __syncthreads();
        }
    }
    {
        LAS float* tile = (LAS float*)lds;
        constexpr int T_IN = 16 * 40, T_OUT = 16 * 16, T_W1 = 16 * 64, T_W2 = 64 * 16, T_ALL = T_IN + T_OUT + T_W1 + T_W2;
        for (int t = bx; t < T_ALL; t += G) {
            if (t < T_IN) { const int kt = t / 40, nt = t % 40; transpose_tile(p.w_in, 2576, (u16*)(ws + WS_WIN), 1024, kt * 64, nt * 64, nt * 64, tile, tid); }
            else if (t < T_IN + T_OUT) { const int q = t - T_IN, kt = q / 16, nt = q % 16; transpose_tile(p.w_out, 1024, (u16*)(ws + WS_WOUT), 1024, kt * 64, nt * 64, nt * 64, tile, tid); }
            else if (t < T_IN + T_OUT + T_W1) { const int q = t - T_IN - T_OUT, kt = q / 64, nt = q % 64; transpose_tile(p.w1, 4096, (u16*)(ws + WS_W1), 1024, kt * 64, nt * 64, nt * 64, tile, tid); }
            else { const int q = t - T_IN - T_OUT - T_W1, kt = q / 16, nt = q % 16; transpose_tile(p.w2, 1024, (u16*)(ws + WS_W2), 4096, kt * 64, nt * 64, nt * 64, tile, tid); }
        }
    }
    {
        const int gt = bx * NTHREADS + tid, gs = G * NTHREADS;
        u16* wg = (u16*)(ws + WS_WG);
        for (int i = gt; i < 16 * 1024; i += gs) { const int n = i >> 10, k = i & 1023; wg[i] = f2bf(p.w_in[(size_t)k * 2576 + 2560 + n]); }
        u16* wsb = (u16*)(ws + WS_WSB);
        for (int i = gt; i < 4 * 128 * 128; i += gs) wsb[i] = f2bf(p.w_s[i]);
    }
}

__device__ __forceinline__ void row_stats(const f32x4 (&v)[4], float& mu, float& rstd) {
    float s = 0.f;
#pragma unroll
    for (int j = 0; j < 4; ++j) s += (v[j][0] + v[j][1]) + (v[j][2] + v[j][3]);
    mu = wsum(s) * (1.0f / 1024.0f);
    float q = 0.f;
#pragma unroll
    for (int j = 0; j < 4; ++j) { const f32x4 d = v[j] - mu; q += (d[0] * d[0] + d[1] * d[1]) + (d[2] * d[2] + d[3] * d[3]); }
    rstd = rsqrtf(wsum(q) * (1.0f / 1024.0f) + LN_EPS_F);
}

__device__ __forceinline__ void phase_ln0(const Params& p) {
    const int lane = threadIdx.x & 63, wave = threadIdx.x >> 6, G = gridDim.x;
    const float* mod = (const float*)(p.ws + WS_MOD);
    u16* hbuf = (u16*)(p.ws + WS_H);
    for (int r = blockIdx.x * 8 + wave; r < MROWS; r += G * 8) {
        const float* src; int mb;
        if (r < NLAT) { src = p.x + (size_t)r * DM; mb = r >> 12; } else { src = p.ctx + (size_t)(r - NLAT) * DM; mb = 8; }
        f32x4 v[4];
#pragma unroll
        for (int j = 0; j < 4; ++j) v[j] = *(const f32x4*)(src + j * 256 + lane * 4);
        float mu, rstd; row_stats(v, mu, rstd);
        const float* sh = mod + mb * NMOD; const float* sc = sh + 1024;
#pragma unroll
        for (int j = 0; j < 4; ++j) {
            const int col = j * 256 + lane * 4;
            const f32x4 s1 = *(const f32x4*)(sc + col), s0 = *(const f32x4*)(sh + col);
            const f32x4 hv = (v[j] - mu) * rstd * (s1 + 1.0f) + s0;
            u32x2 w; w.x = pk2(hv[0], hv[1]); w.y = pk2(hv[2], hv[3]);
            *(u32x2*)(hbuf + (size_t)r * DM + col) = w;
        }
    }
}

__device__ __forceinline__ void phase_ln1(const Params& p) {
    const int lane = threadIdx.x & 63, wave = threadIdx.x >> 6, G = gridDim.x;
    const float* mod = (const float*)(p.ws + WS_MOD);
    u16* hbuf = (u16*)(p.ws + WS_H);
    for (int r = blockIdx.x * 8 + wave; r < NLAT; r += G * 8) {
        float* row = p.out + (size_t)r * DM; const int mb = r >> 12;
        f32x4 v[4];
#pragma unroll
        for (int j = 0; j < 4; ++j) v[j] = *(const f32x4*)(row + j * 256 + lane * 4);
        float mu, rstd; row_stats(v, mu, rstd);
#pragma unroll
        for (int j = 0; j < 4; ++j) {
            const int col = j * 256 + lane * 4;
            const f32x4 g = *(const f32x4*)(p.ln1_g + col), b = *(const f32x4*)(p.ln1_b + col);
            v[j] = (v[j] - mu) * rstd * g + b;
            *(f32x4*)(row + col) = v[j];
        }
        row_stats(v, mu, rstd);
        const float* sh = mod + mb * NMOD + 3 * 1024; const float* sc = sh + 1024;
#pragma unroll
        for (int j = 0; j < 4; ++j) {
            const int col = j * 256 + lane * 4;
            const f32x4 s1 = *(const f32x4*)(sc + col), s0 = *(const f32x4*)(sh + col);
            const f32x4 hv = (v[j] - mu) * rstd * (s1 + 1.0f) + s0;
            u32x2 w; w.x = pk2(hv[0], hv[1]); w.y = pk2(hv[2], hv[3]);
            *(u32x2*)(hbuf + (size_t)r * DM + col) = w;
        }
    }
}

__device__ __forceinline__ void phase_ln2(const Params& p) {
    const int lane = threadIdx.x & 63, wave = threadIdx.x >> 6, G = gridDim.x;
    for (int r = blockIdx.x * 8 + wave; r < NLAT; r += G * 8) {
        float* row = p.out + (size_t)r * DM;
        f32x4 v[4];
#pragma unroll
        for (int j = 0; j < 4; ++j) v[j] = *(const f32x4*)(row + j * 256 + lane * 4);
        float mu, rstd; row_stats(v, mu, rstd);
#pragma unroll
        for (int j = 0; j < 4; ++j) {
            const int col = j * 256 + lane * 4;
            const f32x4 g = *(const f32x4*)(p.ln2_g + col), b = *(const f32x4*)(p.ln2_b + col);
            *(f32x4*)(row + col) = (v[j] - mu) * rstd * g + b;
        }
    }
}

__device__ __forceinline__ void gates_unit(const Params& p, int u) {
    const int lane = threadIdx.x & 63, wave = threadIdx.x >> 6, fr = lane & 15, fq = lane >> 4;
    const u16* hbuf = (const u16*)(p.ws + WS_H); const u16* wg = (const u16*)(p.ws + WS_WG);
    float* gates = (float*)(p.ws + WS_GATES);
    const size_t r0 = (size_t)u * 128 + wave * 16;
    const u16* ap = hbuf + (r0 + fr) * DM + fq * 8; const u16* bp = wg + fr * DM + fq * 8;
    f32x4 acc = {0.f, 0.f, 0.f, 0.f};
#pragma unroll 8
    for (int kk = 0; kk < 32; ++kk) {
        const bf16x8 a = *(const bf16x8*)(ap + kk * 32), b = *(const bf16x8*)(bp + kk * 32);
        acc = __builtin_amdgcn_mfma_f32_16x16x32_bf16(a, b, acc, 0, 0, 0);
    }
    const float bg = p.b_gates[fr];
#pragma unroll
    for (int j = 0; j < 4; ++j) gates[(r0 + fq * 4 + j) * 16 + fr] = acc[j] + bg;
}

__device__ __forceinline__ void conv16(const u16* pb, const float* cw, size_t rb, int pos, int seqlen, int col0, int cc0, float (&o)[16]) {
#pragma unroll
    for (int e = 0; e < 16; ++e) o[e] = 0.f;
#pragma unroll
    for (int d = 0; d < 3; ++d) {
        const int pp = pos + d - 1;
        if (pp >= 0 && pp < seqlen) {
            const u16* src = pb + (rb + pp) * NP + col0;
            const u32x4 a = *(const u32x4*)src, b = *(const u32x4*)(src + 8);
            const float* w = cw + d * 512 + cc0;
            const f32x4 w0 = *(const f32x4*)w, w1 = *(const f32x4*)(w + 4), w2 = *(const f32x4*)(w + 8), w3 = *(const f32x4*)(w + 12);
            o[0] += w0[0] * bflo(a.x); o[1] += w0[1] * bfhi(a.x); o[2] += w0[2] * bflo(a.y); o[3] += w0[3] * bfhi(a.y);
            o[4] += w1[0] * bflo(a.z); o[5] += w1[1] * bfhi(a.z); o[6] += w1[2] * bflo(a.w); o[7] += w1[3] * bfhi(a.w);
            o[8] += w2[0] * bflo(b.x); o[9] += w2[1] * bfhi(b.x); o[10] += w2[2] * bflo(b.y); o[11] += w2[3] * bfhi(b.y);
            o[12] += w3[0] * bflo(b.z); o[13] += w3[1] * bfhi(b.z); o[14] += w3[2] * bflo(b.w); o[15] += w3[3] * bfhi(b.w);
        }
    }
#pragma unroll
    for (int e = 0; e < 16; ++e) o[e] = silu_f(o[e]);
}

__device__ __forceinline__ void gmlp_unit(const Params& p, LAS unsigned char* lds, int u) {
    const int tid = threadIdx.x, lane = tid & 63, wave = tid >> 6, fr = lane & 15, fq = lane >> 4;
    const u16* pb = (const u16*)(p.ws + WS_P); const u16* wsb = (const u16*)(p.ws + WS_WSB);
    u16* ycat = (u16*)(p.ws + WS_YCAT);
    const size_t r0 = (size_t)u * 128;
    LAS u16* vT = (LAS u16*)lds;
    LAS float* mus = (LAS float*)(lds + 34816);
    LAS float* rsd = mus + 128;
    for (int i = 0; i < 16; ++i) {
        const int t = wave * 16 + i;
        const u32x4 a = *(const u32x4*)(pb + (r0 + t) * NP + 512 + lane * 8);
        float x[8] = {bflo(a.x), bfhi(a.x), bflo(a.y), bfhi(a.y), bflo(a.z), bfhi(a.z), bflo(a.w), bfhi(a.w)};
        float s = 0.f;
#pragma unroll
        for (int e = 0; e < 8; ++e) s += x[e];
        const float mu = wsum(s) * (1.0f / 512.0f);
        float q = 0.f;
#pragma unroll
        for (int e = 0; e < 8; ++e) { const float d = x[e] - mu; q += d * d; }
        const float rs = rsqrtf(wsum(q) * (1.0f / 512.0f) + LN_EPS_F);
        if (lane == 0) { mus[t] = mu; rsd[t] = rs; }
    }
    for (int g = 0; g < 4; ++g) {
        __syncthreads();
        {
            const int part = tid >> 7, s = tid & 127;
            const float mu = mus[s], rs = rsd[s];
            const u16* src = pb + (r0 + s) * NP + 512 + g * 128 + part * 32;
            const float* gv = p.ln_v_g + g * 128 + part * 32; const float* bv = p.ln_v_b + g * 128 + part * 32;
#pragma unroll
            for (int q4 = 0; q4 < 4; ++q4) {
                const u32x4 a = *(const u32x4*)(src + q4 * 8);
                const float x[8] = {bflo(a.x), bfhi(a.x), bflo(a.y), bfhi(a.y), bflo(a.z), bfhi(a.z), bflo(a.w), bfhi(a.w)};
#pragma unroll
                for (int e = 0; e < 8; ++e) { const int d = q4 * 8 + e; vT[(part * 32 + d) * 136 + s] = f2bf((x[e] - mu) * rs * gv[d] + bv[d]); }
            }
        }
        __syncthreads();
        f32x4 acc[8];
#pragma unroll
        for (int nb = 0; nb < 8; ++nb) acc[nb] = (f32x4){0.f, 0.f, 0.f, 0.f};
        const u16* ap = wsb + (size_t)g * 16384 + (wave * 16 + fr) * 128 + fq * 8;
#pragma unroll
        for (int kk = 0; kk < 4; ++kk) {
            const bf16x8 a = *(const bf16x8*)(ap + kk * 32);
#pragma unroll
            for (int nb = 0; nb < 8; ++nb) {
                const bf16x8 b = *(const LAS bf16x8*)(vT + (nb * 16 + fr) * 136 + kk * 32 + fq * 8);
                acc[nb] = __builtin_amdgcn_mfma_f32_16x16x32_bf16(a, b, acc[nb], 0, 0, 0);
            }
        }
#pragma unroll
        for (int j = 0; j < 4; ++j) {
            const int t = wave * 16 + fq * 4 + j; const float bs = p.b_s[g * 128 + t];
#pragma unroll
            for (int nb = 0; nb < 8; ++nb) {
                const int d = nb * 16 + fr;
                const float uu = bf2f(pb[(r0 + t) * NP + g * 128 + d]);
                ycat[(r0 + t) * DM + g * 128 + d] = f2bf(uu * (acc[nb][j] + bs));
            }
        }
    }
    __syncthreads();
}

__device__ __forceinline__ void state_unit(const Params& p, LAS unsigned char* lds, int u) {
    const int tid = threadIdx.x, lane = tid & 63, wave = tid >> 6, fr = lane & 15, fq = lane >> 4;
    const u16* pb = (const u16*)(p.ws + WS_P);
    const float* gates = (const float*)(p.ws + WS_GATES);
    float* U = (float*)(p.ws + WS_U); float* nU = (float*)(p.ws + WS_NU);
    float* gl = (float*)(p.ws + WS_GL); float* ml = (float*)(p.ws + WS_ML);
    const int c = u % NCH, bh = u / NCH, h = bh & 3, b = bh >> 2;
    size_t rb; int seqlen, cpos;
    if (c < 2) { rb = (size_t)NLAT + b * 256; seqlen = 256; cpos = c; } else { rb = (size_t)b * 4096; seqlen = 4096; cpos = c - 2; }
    const size_t r0 = rb + cpos * 128;
    LAS u16* kwT = (LAS u16*)lds;
    LAS u16* vT = (LAS u16*)(lds + 34816);
    LAS float* wl = (LAS float*)(lds + 69632);
    if (wave < 2) {
        const int dir = wave;
        const int j0 = dir ? 127 - 2 * lane : 2 * lane, j1 = dir ? 126 - 2 * lane : 2 * lane + 1;
        const float gi0 = gates[(r0 + j0) * 16 + dir * 8 + h], gf0 = gates[(r0 + j0) * 16 + dir * 8 + 4 + h];
        const float gi1 = gates[(r0 + j1) * 16 + dir * 8 + h], gf1 = gates[(r0 + j1) * 16 + dir * 8 + 4 + h];
        const float lf0 = logsigmoid_f(gf0), lf1 = logsigmoid_f(gf1);
        const float incl = wscan_add(lf0 + lf1, lane);
        const float b0 = incl - lf1, b1 = incl;
        const float tot = __shfl(incl, 63);
        const float d0 = tot - b0 + gi0, d1 = tot - b1 + gi1;
        const float mloc = wmaxr(fmaxf(d0, d1));
        wl[dir * 128 + j0] = __expf(d0 - mloc); wl[dir * 128 + j1] = __expf(d1 - mloc);
        if (lane == 0) { const int scan = bh * 2 + dir; gl[scan * NCH + c] = tot; ml[scan * NCH + c] = mloc; }
    }
    __syncthreads();
    {
        const int part = tid >> 7, j = tid & 127;
        float kc[16];
        conv16(pb, p.conv_qk, rb, cpos * 128 + j, seqlen, 1280 + h * 64 + part * 16, 256 + h * 64 + part * 16, kc);
        const float wf = wl[j], wb = wl[128 + j];
#pragma unroll
        for (int e = 0; e < 16; ++e) { kwT[(part * 16 + e) * 136 + j] = f2bf(wf * kc[e]); kwT[(64 + part * 16 + e) * 136 + j] = f2bf(wb * kc[e]); }
        const u16* src = pb + (r0 + j) * NP + 1536 + h * 128 + part * 32;
#pragma unroll
        for (int q4 = 0; q4 < 4; ++q4) {
            const u32x4 a = *(const u32x4*)(src + q4 * 8);
            const unsigned wv[4] = {a.x, a.y, a.z, a.w};
#pragma unroll
            for (int e = 0; e < 4; ++e) { vT[(part * 32 + q4 * 8 + 2 * e) * 136 + j] = (u16)(wv[e] & 0xffffu); vT[(part * 32 + q4 * 8 + 2 * e + 1) * 136 + j] = (u16)(wv[e] >> 16); }
        }
    }
    __syncthreads();
    f32x4 acc[8];
#pragma unroll
    for (int nb = 0; nb < 8; ++nb) acc[nb] = (f32x4){0.f, 0.f, 0.f, 0.f};
    wmma_lds<8, 4>(vT + wave * 16 * 136, 136, kwT, 136, acc, fr, fq);
#pragma unroll
    for (int nb = 0; nb < 8; ++nb) {
        const int dir = nb >> 2, kk = (nb & 3) * 16 + fr, scan = bh * 2 + dir;
#pragma unroll
        for (int j = 0; j < 4; ++j) { const int vv = wave * 16 + fq * 4 + j; U[(((size_t)scan * NCH + c) * 128 + vv) * 64 + kk] = acc[nb][j]; }
    }
    if (tid < 128) {
        const int dir = tid >> 6, kk = tid & 63, scan = bh * 2 + dir; float s = 0.f;
        for (int j = 0; j < 128; ++j) s += bf2f(kwT[tid * 136 + j]);
        nU[((size_t)scan * NCH + c) * 64 + kk] = s;
    }
    __syncthreads();
}

__device__ __forceinline__ void phase_scan(const Params& p) {
    const float* U = (const float*)(p.ws + WS_U); const float* nU = (const float*)(p.ws + WS_NU);
    const float* gl = (const float*)(p.ws + WS_GL); const float* ml = (const float*)(p.ws + WS_ML);
    u16* cin = (u16*)(p.ws + WS_CIN); float* nin = (float*)(p.ws + WS_NIN); float* min_ = (float*)(p.ws + WS_MIN);
    const int gs = gridDim.x * NTHREADS;
    for (int item = blockIdx.x * NTHREADS + threadIdx.x; item < 64 * 2048; item += gs) {
        const int scan = item >> 11, q = item & 2047, dir = scan & 1;
        f32x4 C = {0.f, 0.f, 0.f, 0.f}, n = {0.f, 0.f, 0.f, 0.f}; float m = 0.f;
        const bool hasn = q < 16;
        int c = dir ? 1 : 0;
        f32x4 Un = *(const f32x4*)(U + (((size_t)scan * NCH + c) * 2048 + q) * 4);
        f32x4 nn = hasn ? *(const f32x4*)(nU + ((size_t)scan * NCH + c) * 64 + q * 4) : (f32x4){0.f, 0.f, 0.f, 0.f};
        for (int step = 0; step < NCH; ++step) {
            const f32x4 Uc = Un, nc = nn; const int cc = c;
            if (step + 1 < NCH) {
                const int s1 = step + 1;
                c = dir ? (s1 == 1 ? 0 : 35 - s1) : s1;
                Un = *(const f32x4*)(U + (((size_t)scan * NCH + c) * 2048 + q) * 4);
                if (hasn) nn = *(const f32x4*)(nU + ((size_t)scan * NCH + c) * 64 + q * 4);
            }
            const float g = gl[scan * NCH + cc], mlc = ml[scan * NCH + cc];
            if (cc >= 2) {
                const int cl = cc - 2;
                u32x2 w; w.x = pk2(C[0], C[1]); w.y = pk2(C[2], C[3]);
                *(u32x2*)(cin + (((size_t)scan * 32 + cl) * 2048 + q) * 4) = w;
                if (hasn) *(f32x4*)(nin + ((size_t)scan * 32 + cl) * 64 + q * 4) = n;
                if (q == 0) min_[scan * 32 + cl] = m;
            }
            const float mn = fmaxf(g + m, mlc), a = __expf(g + m - mn), s = __expf(mlc - mn);
            C = C * a + Uc * s; n = n * a + nc * s; m = mn;
        }
    }
}

__device__ __forceinline__ void out_unit(const Params& p, LAS unsigned char* lds, int u) {
    const int tid = threadIdx.x, lane = tid & 63, wave = tid >> 6, fr = lane & 15, fq = lane >> 4;
    const u16* pb = (const u16*)(p.ws + WS_P);
    const float* gates = (const float*)(p.ws + WS_GATES);
    const u16* cin = (const u16*)(p.ws + WS_CIN); const float* nin = (const float*)(p.ws + WS_NIN); const float* min_ = (const float*)(p.ws + WS_MIN);
    u16* ycat = (u16*)(p.ws + WS_YCAT);
    const int n = u & 31, bh = u >> 5, h = bh & 3, b = bh >> 2;
    const size_t rb = (size_t)b * 4096, r0 = rb + n * 128;
    LAS u16* qs = (LAS u16*)lds;
    LAS u16* ks = (LAS u16*)(lds + 18432);
    LAS u16* vT = (LAS u16*)(lds + 36864);
    LAS u16* cT = (LAS u16*)(lds + 76032);
    LAS u16* sp = (LAS u16*)(lds + 96768);
    LAS float* aA = (LAS float*)(lds + 131584);
    LAS float* MM = aA + 256;
    LAS float* BB = MM + 256;
    LAS float* m0s = BB + 256;
    if (wave < 2) {
        const int dir = wave, scan = bh * 2 + dir;
        const float m0 = min_[scan * 32 + n];
        const int j0 = dir ? 127 - 2 * lane : 2 * lane, j1 = dir ? 126 - 2 * lane : 2 * lane + 1;
        const float gi0 = gates[(r0 + j0) * 16 + dir * 8 + h], gf0 = gates[(r0 + j0) * 16 + dir * 8 + 4 + h];
        const float gi1 = gates[(r0 + j1) * 16 + dir * 8 + h], gf1 = gates[(r0 + j1) * 16 + dir * 8 + 4 + h];
        const float lf0 = logsigmoid_f(gf0), lf1 = logsigmoid_f(gf1);
        const float incl = wscan_add(lf0 + lf1, lane);
        const float b0 = incl - lf1, b1 = incl;
        const float a0 = gi0 - b0, a1 = gi1 - b1;
        const float im = wscan_max(fmaxf(a0, a1), lane);
        float ex = __shfl_up(im, 1); if (lane == 0) ex = -INFINITY;
        const float M0 = fmaxf(m0, fmaxf(ex, a0)), M1 = fmaxf(m0, im);
        aA[dir * 128 + j0] = a0; aA[dir * 128 + j1] = a1;
        MM[dir * 128 + j0] = M0; MM[dir * 128 + j1] = M1;
        BB[dir * 128 + j0] = b0; BB[dir * 128 + j1] = b1;
        if (lane == 0) m0s[dir] = m0;
    }
    {
        const int part = tid >> 7, j = tid & 127;
        float t16[16];
        conv16(pb, p.conv_qk, rb, n * 128 + j, 4096, 1024 + h * 64 + part * 16, h * 64 + part * 16, t16);
        {
            u32x4 w0, w1;
            w0.x = pk2(t16[0] * 0.125f, t16[1] * 0.125f); w0.y = pk2(t16[2] * 0.125f, t16[3] * 0.125f); w0.z = pk2(t16[4] * 0.125f, t16[5] * 0.125f); w0.w = pk2(t16[6] * 0.125f, t16[7] * 0.125f);
            w1.x = pk2(t16[8] * 0.125f, t16[9] * 0.125f); w1.y = pk2(t16[10] * 0.125f, t16[11] * 0.125f); w1.z = pk2(t16[12] * 0.125f, t16[13] * 0.125f); w1.w = pk2(t16[14] * 0.125f, t16[15] * 0.125f);
            *(LAS u32x4*)(qs + j * 72 + part * 16) = w0; *(LAS u32x4*)(qs + j * 72 + part * 16 + 8) = w1;
        }
        conv16(pb, p.conv_qk, rb, n * 128 + j, 4096, 1280 + h * 64 + part * 16, 256 + h * 64 + part * 16, t16);
        {
            u32x4 w0, w1;
            w0.x = pk2(t16[0], t16[1]); w0.y = pk2(t16[2], t16[3]); w0.z = pk2(t16[4], t16[5]); w0.w = pk2(t16[6], t16[7]);
            w1.x = pk2(t16[8], t16[9]); w1.y = pk2(t16[10], t16[11]); w1.z = pk2(t16[12], t16[13]); w1.w = pk2(t16[14], t16[15]);
            *(LAS u32x4*)(ks + j * 72 + part * 16) = w0; *(LAS u32x4*)(ks + j * 72 + part * 16 + 8) = w1;
        }
        const u16* src = pb + (r0 + j) * NP + 1536 + h * 128 + part * 32;
#pragma unroll
        for (int q4 = 0; q4 < 4; ++q4) {
            const u32x4 a = *(const u32x4*)(src + q4 * 8);
            const unsigned wv[4] = {a.x, a.y, a.z, a.w};
#pragma unroll
            for (int e = 0; e < 4; ++e) { vT[(part * 32 + q4 * 8 + 2 * e) * 136 + j] = (u16)(wv[e] & 0xffffu); vT[(part * 32 + q4 * 8 + 2 * e + 1) * 136 + j] = (u16)(wv[e] >> 16); }
        }
        if (tid < 128) vT[128 * 136 + tid] = (u16)0x3F80u;
        for (int i = tid; i < 15 * 136; i += NTHREADS) vT[129 * 136 + i] = (u16)0;
        for (int i = tid; i < 15 * 72; i += NTHREADS) cT[129 * 72 + i] = (u16)0;
    }
    f32x4 hs[8];
#pragma unroll
    for (int nb = 0; nb < 8; ++nb) hs[nb] = (f32x4){0.f, 0.f, 0.f, 0.f};
    for (int dir = 0; dir < 2; ++dir) {
        const int scan = bh * 2 + dir;
        {
            const int vv = tid >> 2, seg = (tid & 3) * 16;
            const u16* src = cin + (((size_t)scan * 32 + n) * 128 + vv) * 64 + seg;
            const u32x4 a = *(const u32x4*)src, bq = *(const u32x4*)(src + 8);
            *(LAS u32x4*)(cT + vv * 72 + seg) = a; *(LAS u32x4*)(cT + vv * 72 + seg + 8) = bq;
            if (tid < 64) cT[128 * 72 + tid] = f2bf(nin[((size_t)scan * 32 + n) * 64 + tid]);
        }
        __syncthreads();
        f32x4 accs[8];
#pragma unroll
        for (int nb = 0; nb < 8; ++nb) accs[nb] = (f32x4){0.f, 0.f, 0.f, 0.f};
        wmma_lds<8, 2>(qs + wave * 16 * 72, 72, ks, 72, accs, fr, fq);
#pragma unroll
        for (int j = 0; j < 4; ++j) {
            const int t = wave * 16 + fq * 4 + j; const float Mt = MM[dir * 128 + t];
#pragma unroll
            for (int nb = 0; nb < 8; ++nb) {
                const int s = nb * 16 + fr;
                const bool valid = dir ? (s >= t) : (s <= t);
                const float val = valid ? accs[nb][j] * __expf(aA[dir * 128 + s] - Mt) : 0.f;
                sp[(wave * 16 + fq * 4 + j) * 136 + s] = f2bf(val);
            }
        }
        __syncthreads();
        f32x4 accn[9];
#pragma unroll
        for (int nb = 0; nb < 9; ++nb) accn[nb] = (f32x4){0.f, 0.f, 0.f, 0.f};
        wmma_lds<9, 4>(sp + wave * 16 * 136, 136, vT, 136, accn, fr, fq);
        {
            const float sc = __expf(m0s[dir] - MM[dir * 128 + wave * 16 + fr]);
#pragma unroll
            for (int kk = 0; kk < 2; ++kk) {
                const u32x4 qa = *(const LAS u32x4*)(qs + (wave * 16 + fr) * 72 + kk * 32 + fq * 8);
                u32x4 qb;
                qb.x = pk2(bflo(qa.x) * sc, bfhi(qa.x) * sc); qb.y = pk2(bflo(qa.y) * sc, bfhi(qa.y) * sc);
                qb.z = pk2(bflo(qa.z) * sc, bfhi(qa.z) * sc); qb.w = pk2(bflo(qa.w) * sc, bfhi(qa.w) * sc);
                const bf16x8 a = __builtin_bit_cast(bf16x8, qb);
#pragma unroll
                for (int nb = 0; nb < 9; ++nb) {
                    const bf16x8 bb = *(const LAS bf16x8*)(cT + (nb * 16 + fr) * 72 + kk * 32 + fq * 8);
                    accn[nb] = __builtin_amdgcn_mfma_f32_16x16x32_bf16(a, bb, accn[nb], 0, 0, 0);
                }
            }
        }
#pragma unroll
        for (int j = 0; j < 4; ++j) {
            const int t = wave * 16 + fq * 4 + j;
            const float den = __shfl(accn[8][j], lane & 48);
            const float lim = __expf(-(BB[dir * 128 + t] + MM[dir * 128 + t]));
            const float inv = 1.0f / fmaxf(fabsf(den), lim);
#pragma unroll
            for (int nb = 0; nb < 8; ++nb) hs[nb][j] += accn[nb][j] * inv;
        }
        __syncthreads();
    }
#pragma unroll
    for (int j = 0; j < 4; ++j) {
        const int t = wave * 16 + fq * 4 + j;
        float s = 0.f;
#pragma unroll
        for (int nb = 0; nb < 8; ++nb) s += hs[nb][j];
        s += __shfl_xor(s, 1); s += __shfl_xor(s, 2); s += __shfl_xor(s, 4); s += __shfl_xor(s, 8);
        const float mu = s * (1.0f / 128.0f);
        float q = 0.f;
#pragma unroll
        for (int nb = 0; nb < 8; ++nb) { const float d = hs[nb][j] - mu; q += d * d; }
        q += __shfl_xor(q, 1); q += __shfl_xor(q, 2); q += __shfl_xor(q, 4); q += __shfl_xor(q, 8);
        const float rs = rsqrtf(q * (1.0f / 128.0f) + LN_EPS_F);
#pragma unroll
        for (int nb = 0; nb < 8; ++nb) {
            const int vv = nb * 16 + fr;
            const float o = bf2f(pb[(r0 + t) * NP + 2048 + h * 128 + vv]);
            const float y = (hs[nb][j] - mu) * rs * p.hn_g[h * 128 + vv] * sigmoid_f(o);
            ycat[(r0 + t) * DM + 512 + h * 128 + vv] = f2bf(y);
        }
    }
}

struct EpiResid {
    static constexpr bool PERM = false, AFTER_DRAIN = false;
    const float* src; float* out; const float* gate; const float* bias;
    __device__ __forceinline__ void operator()(const pg8::f32x4 (&acc)[2][2][4][2], const pg8::Unit& u, int wr, int wc, int fr, int fq) const {
        const int row0 = u.pm * 256 + wr * 64 + fr, col0 = u.pn * 256 + wc * 32 + 4 * fq;
        const float* gp = gate + (size_t)(u.pm >> 4) * NMOD;
#pragma unroll
        for (int bj = 0; bj < 2; ++bj)
#pragma unroll
            for (int n = 0; n < 2; ++n) {
                const int cidx = col0 + bj * 128 + n * 16;
                const f32x4 gv = *(const f32x4*)(gp + cidx);
                const f32x4 bv = bias ? *(const f32x4*)(bias + cidx) : (f32x4){0.f, 0.f, 0.f, 0.f};
#pragma unroll
                for (int ai = 0; ai < 2; ++ai)
#pragma unroll
                    for (int m = 0; m < 4; ++m) {
                        const size_t off = (size_t)(row0 + ai * 128 + m * 16) * DM + cidx;
                        const f32x4 xs = *(const f32x4*)(src + off);
                        *(f32x4*)(out + off) = xs * ALPHA_F + gv * (acc[ai][bj][m][n] + bv);
                    }
            }
    }
};

#ifndef PH_MASK
#define PH_MASK 0x7FF
#endif
#define PHM(k) (((PH_MASK) >> (k)) & 1)
__global__ void __launch_bounds__(NTHREADS, 2) mega(Params p) {
    extern __shared__ __attribute__((aligned(16))) unsigned char smem[];
    LAS unsigned char* lds = (LAS unsigned char*)smem;
    cg::grid_group grid = cg::this_grid();
    const int G = gridDim.x, bx = blockIdx.x;
    unsigned char* ws = p.ws;
    const int lo = p.ph_lo, hi = p.ph_hi;
#define IN(k) (PHM(k) && lo <= (k) && (k) <= hi)
#define SEAM(k) do { if ((k) < hi) grid.sync(); } while (0)
    if (IN(0)) { phase_prep(p, lds); SEAM(0); }
    if (IN(1)) { phase_ln0(p); SEAM(1); }
    if (IN(2)) {
            pg8::Gemm g{(const pg8::bf16_t*)(ws + WS_H), (const pg8::bf16_t*)(ws + WS_WIN), MROWS, NP, DM};
            pg8::StaticOrder S; S.init(MROWS, NP, G, bx);
            pg8::EpiBf16<0> E{(pg8::bf16_t*)(ws + WS_P), NP, nullptr, 0, 0};
            pg8::gemm_phase<pg8::EpiBf16<0>, pg8::StaticOrder, false>(lds, g, S, E, nullptr);
            for (int u = G - 1 - bx; u < MROWS / 128; u += G) gates_unit(p, u);
        SEAM(2);
    }
    if (IN(3)) {
            for (int u = bx; u < 1088 + 256; u += G) { if (u < 1088) state_unit(p, lds, u); else gmlp_unit(p, lds, u - 1088); }
        SEAM(3);
    }
    if (IN(4)) { phase_scan(p); SEAM(4); }
    if (IN(5)) { for (int u = bx; u < 1024; u += G) out_unit(p, lds, u); SEAM(5); }
    if (IN(6)) {
            pg8::Gemm g{(const pg8::bf16_t*)(ws + WS_YCAT), (const pg8::bf16_t*)(ws + WS_WOUT), NLAT, DM, DM};
            pg8::StaticOrder S; S.init(NLAT, DM, G, bx);
            EpiResid E{p.x, p.out, (const float*)(ws + WS_MOD) + 2 * 1024, nullptr};
            pg8::gemm_phase<EpiResid, pg8::StaticOrder, false>(lds, g, S, E, nullptr);
        SEAM(6);
    }
    if (IN(7)) { phase_ln1(p); SEAM(7); }
    if (IN(8)) {
            pg8::Gemm g{(const pg8::bf16_t*)(ws + WS_H), (const pg8::bf16_t*)(ws + WS_W1), NLAT, DFF, DM};
            pg8::StaticOrder S; S.init(NLAT, DFF, G, bx);
            pg8::EpiBf16<3> E{(pg8::bf16_t*)(ws + WS_A), DFF, p.b1, 0, 0};
            pg8::gemm_phase<pg8::EpiBf16<3>, pg8::StaticOrder, false>(lds, g, S, E, nullptr);
        SEAM(8);
    }
    if (IN(9)) {
            pg8::Gemm g{(const pg8::bf16_t*)(ws + WS_A), (const pg8::bf16_t*)(ws + WS_W2), NLAT, DM, DFF};
            pg8::StaticOrder S; S.init(NLAT, DM, G, bx);
            EpiResid E{p.out, p.out, (const float*)(ws + WS_MOD) + 5 * 1024, p.b2};
            pg8::gemm_phase<EpiResid, pg8::StaticOrder, false>(lds, g, S, E, nullptr);
        SEAM(9);
    }
    if (IN(10)) { phase_ln2(p); }
#undef IN
#undef SEAM
}

constexpr int NPHASES = 11;
#ifndef N_LAUNCH_MODE
#define N_LAUNCH_MODE 0
#endif

extern "C" void kernel_launch(void* const* d_in, const int* in_sizes, int n_in, void* d_out, int out_size, void* d_ws, size_t ws_size, hipStream_t stream) {
    static int grid = 0;
    if (grid == 0) {
        if (n_in != 23 || ws_size < WS_END) { fprintf(stderr, "kernel_launch: unexpected n_in %d or ws_size %zu (< %zu)\n", n_in, ws_size, (size_t)WS_END); grid = -1; return; }
        int dev = 0, cus = 0, per_cu = 0;
        hipGetDevice(&dev);
        hipDeviceGetAttribute(&cus, hipDeviceAttributeMultiprocessorCount, dev);
        if (hipFuncSetAttribute((const void*)mega, hipFuncAttributeMaxDynamicSharedMemorySize, LDS_BYTES) != hipSuccess) { fprintf(stderr, "kernel_launch: hipFuncSetAttribute failed\n"); grid = -1; return; }
        if (hipOccupancyMaxActiveBlocksPerMultiprocessor(&per_cu, (const void*)mega, NTHREADS, LDS_BYTES) != hipSuccess || per_cu < 1) { fprintf(stderr, "kernel_launch: occupancy query says %d\n", per_cu); per_cu = 1; (void)hipGetLastError(); }
        if (per_cu > 1) per_cu = 1;
        grid = cus * per_cu;
    }
    if (grid < 0) return;
    Params p{};
    const float** pf = (const float**)&p;
    for (int i = 0; i < 23; ++i) pf[i] = (const float*)d_in[i];
    p.out = (float*)d_out; p.ws = (unsigned char*)d_ws;
#if N_LAUNCH_MODE == 1
    for (int ph = 0; ph < NPHASES; ++ph) { p.ph_lo = ph; p.ph_hi = ph; hipLaunchKernelGGL(mega, dim3(grid), dim3(NTHREADS), LDS_BYTES, stream, p); }
#else
    p.ph_lo = 0; p.ph_hi = NPHASES - 1;
    void* args[] = {&p};
    hipError_t e = hipLaunchCooperativeKernel((const void*)mega, dim3(grid), dim3(NTHREADS), args, LDS_BYTES, stream);
    if (e != hipSuccess) fprintf(stderr, "cooperative launch failed: %s (grid %d)\n", hipGetErrorString(e), grid);
#endif
}
```

```cpp
#define N_LAUNCH_MODE 0
#include <hip/hip_runtime.h>
#include <hip/hip_cooperative_groups.h>
#include <cstdio>
namespace pg8 {
#define PG8_LAS __attribute__((address_space(3)))
typedef unsigned short bf16_t;
typedef short bf16x8 __attribute__((ext_vector_type(8)));
typedef float f32x4 __attribute__((ext_vector_type(4)));
typedef unsigned u32x4 __attribute__((ext_vector_type(4)));
constexpr int BM = 256, BK = 64, HALF = 128, HTB = HALF * BK * 2  , STAGE_BYTES = 8 * HTB, NXCD = 8, WGM = 8;

__host__ __device__ __forceinline__ int lds_byte(int r, int c) { const int st = (r >> 4) * 2 + (c >> 5), rr = r & 15, cc = c & 31, ob = rr * 64 + cc * 2; return st * 1024 + (ob ^ (((ob >> 9) & 1) << 5)); }
__host__ __device__ __forceinline__ void stage_rc(int b, int& R, int& C) { const int st = b / 1024, sb = b % 1024, swz = sb ^ (((sb >> 9) & 1) << 5); R = (st >> 1) * 16 + swz / 64; C = (st & 1) * 32 + (swz % 64) / 2; }
__host__ __device__ __forceinline__ int perm32(int rho) { const int n = rho >> 4, i = rho & 15; return 8 * (i >> 2) + 4 * n + (i & 3); }

struct Unit { int pm, pn; };
struct Gemm { const bf16_t* A; const bf16_t* Bt; int M, N, K; };

struct StaticOrder {
    int nM, nN, nwg, G, c;
    __host__ __device__ void init(int M, int N, int G_, int c_) { nM = M / BM; nN = N / BM; nwg = nM * nN; G = G_; c = c_; }
    __host__ __device__ bool next(int i, Unit& u) const {
        const long L = (long)i * G + c; if (L >= nwg) return false;
        int wgid = (int)L; { const int q = nwg / NXCD, r = nwg % NXCD, xcd = wgid % NXCD, off = wgid / NXCD; wgid = (xcd < r ? xcd * (q + 1) : r * (q + 1) + (xcd - r) * q) + off; }
        const int nig = WGM * nN, gid = wgid / nig, fm = gid * WGM, gsz = (nM - fm) < WGM ? (nM - fm) : WGM;
        u.pm = fm + ((wgid % nig) % gsz); u.pn = (wgid % nig) / gsz; return true;
    }
    __device__ __forceinline__ void a_ready(const Unit&) const {}
    __device__ __forceinline__ void done(const Unit&) const {}
};
__device__ __forceinline__ unsigned cvt_pk_bf16(float lo, float hi) { unsigned r; asm volatile("v_cvt_pk_bf16_f32 %0, %1, %2" : "=v"(r) : "v"(lo), "v"(hi)); return r; }
typedef float f32x2 __attribute__((ext_vector_type(2)));
__device__ __forceinline__ f32x2 gelu_pk(f32x2 v) {
    const f32x2 av = __builtin_elementwise_abs(v), d = av * 0.2316418882f + 1.0f;
    f32x2 t; t.x = __builtin_amdgcn_rcpf(d.x); t.y = __builtin_amdgcn_rcpf(d.y);
    f32x2 q = t * 0.5307027145f + (-0.7265760135f); q = q * t + 0.7107068705f; q = q * t + (-0.142248368f); q = q * t + 0.127414796f; q = q * t;
    const f32x2 s = (v * v) * (-0.72134752044f);
    f32x2 e; e.x = __builtin_amdgcn_exp2f(s.x); e.y = __builtin_amdgcn_exp2f(s.y);
    const f32x2 m = v * (q * e), r = v - m;
    f32x2 o; o.x = v.x < 0.f ? m.x : r.x; o.y = v.y < 0.f ? m.y : r.y; return o;
}

struct EpiF32 {
    static constexpr bool PERM = false, AFTER_DRAIN = false;
    float* C; int ldc; const float* bias;
    __device__ __forceinline__ void operator()(const f32x4 (&acc)[2][2][4][2], const Unit& u, int wr, int wc, int fr, int fq) const {
        const int row0 = u.pm * BM + wr * 64 + fr, col0 = u.pn * BM + wc * 32 + 4 * fq;
        f32x4 bv[2][2];
#pragma unroll
        for (int bj = 0; bj < 2; ++bj)
#pragma unroll
            for (int n = 0; n < 2; ++n) bv[bj][n] = bias ? *(const f32x4*)(bias + col0 + bj * HALF + n * 16) : (f32x4){0.f, 0.f, 0.f, 0.f};
#pragma unroll
        for (int ai = 0; ai < 2; ++ai)
#pragma unroll
            for (int m = 0; m < 4; ++m) { float* rowp = C + (size_t)(row0 + ai * HALF + m * 16) * ldc + col0;
#pragma unroll
                for (int bj = 0; bj < 2; ++bj)
#pragma unroll
                    for (int n = 0; n < 2; ++n) *(f32x4*)(rowp + bj * HALF + n * 16) = acc[ai][bj][m][n] + bv[bj][n]; }
    }
};
template <int ACT  > struct EpiBf16 {
    static constexpr bool PERM = true, AFTER_DRAIN = false;
    bf16_t* O; int ldc; const float* bias; int split_cols; size_t split_stride;
    __device__ __forceinline__ void operator()(const f32x4 (&acc)[2][2][4][2], const Unit& u, int wr, int wc, int fr, int fq) const {
        const int row0 = u.pm * BM + wr * 64 + fr; int colt = u.pn * BM; bf16_t* base = O;
        if (split_cols) { const int t = colt / split_cols; base += (size_t)t * split_stride; colt -= t * split_cols; }
        const int col0 = colt + wc * 32 + 8 * fq, bcol0 = u.pn * BM + wc * 32 + 8 * fq;
        f32x4 bv[2][2];
#pragma unroll
        for (int bj = 0; bj < 2; ++bj)
#pragma unroll
            for (int n = 0; n < 2; ++n) bv[bj][n] = bias ? *(const f32x4*)(bias + bcol0 + bj * HALF + 4 * n) : (f32x4){0.f, 0.f, 0.f, 0.f};
#pragma unroll
        for (int ai = 0; ai < 2; ++ai)
#pragma unroll
            for (int m = 0; m < 4; ++m) { bf16_t* rowp = base + (size_t)(row0 + ai * HALF + m * 16) * ldc + col0;
#pragma unroll
                for (int bj = 0; bj < 2; ++bj) { f32x4 v0 = acc[ai][bj][m][0] + bv[bj][0], v1 = acc[ai][bj][m][1] + bv[bj][1];
                    if (ACT == 1) { f32x2 a = gelu_pk((f32x2){v0[0], v0[1]}), b = gelu_pk((f32x2){v0[2], v0[3]}), c = gelu_pk((f32x2){v1[0], v1[1]}), d = gelu_pk((f32x2){v1[2], v1[3]});
                        v0 = (f32x4){a.x, a.y, b.x, b.y}; v1 = (f32x4){c.x, c.y, d.x, d.y}; }
                    if (ACT == 2) {
#pragma unroll
                        for (int j = 0; j < 4; ++j) { v0[j] = 0.5f * v0[j] * (1.0f + erff(v0[j] * 0.70710678f)); v1[j] = 0.5f * v1[j] * (1.0f + erff(v1[j] * 0.70710678f)); } }
                    if (ACT == 3) {
#pragma unroll
                        for (int j = 0; j < 4; ++j) { const float a0 = fmaxf(v0[j], 0.f), a1 = fmaxf(v1[j], 0.f); v0[j] = a0 * a0; v1[j] = a1 * a1; } }
                    u32x4 w; w.x = cvt_pk_bf16(v0[0], v0[1]); w.y = cvt_pk_bf16(v0[2], v0[3]); w.z = cvt_pk_bf16(v1[0], v1[1]); w.w = cvt_pk_bf16(v1[2], v1[3]);
                    *(u32x4*)(rowp + bj * HALF) = w; } }
    }
};
template <class Epi, class Sched, bool STAMP = false>
__device__ __forceinline__ void gemm_phase(PG8_LAS unsigned char* lds, const Gemm g, const Sched& S, const Epi& E, unsigned long long* stamps) {
    const int tid = threadIdx.x, wid = __builtin_amdgcn_readfirstlane(tid >> 6), lane = tid & 63, wr = wid >> 2, wc = wid & 3, fr = lane & 15, fq = lane >> 4;
    const int K = g.K, nt = K / BK;
    int ts_lo = 0, ts_hi = 0, nts = 0; const unsigned long long rt_entry = STAMP ? (unsigned long long)wall_clock64() : 0ull;
#define PG8_STAMP() do { if (STAMP && wid == 0 && nts < 64) { const unsigned long long _c = (unsigned long long)clock64(); \
        ts_lo = (lane == nts) ? (int)(unsigned)_c : ts_lo; ts_hi = (lane == nts) ? (int)(unsigned)(_c >> 32) : ts_hi; ++nts; } } while (0)
    PG8_STAMP();
    unsigned voffA[2], voffB[2];
#pragma unroll
    for (int i = 0; i < 2; ++i) { int R, C; stage_rc(tid * 16 + i * 8192, R, C); const int Rb = Epi::PERM ? ((R & ~31) + perm32(R & 31)) : R;
        voffA[i] = (unsigned)(R * K + C) * 2u; voffB[i] = (unsigned)(Rb * K + C) * 2u; }
    const size_t kstep = (size_t)(BK * 2);
    const size_t hstep = (size_t)HALF * K * 2;
    const size_t tstep = 2 * hstep;
    const unsigned ldsw = (unsigned)wid * 1024u;
    const int aoff = lds_byte(wr * 64 + fr, fq * 8), boff = lds_byte(wc * 32 + fr, fq * 8);
#define PG8_SA(b, h) (((b) * 2 + (h)) * HTB)
#define PG8_SB(b, h) ((4 + (b) * 2 + (h)) * HTB)
#define PG8_STAGE(bufoff, gbase, voff) do { _Pragma("unroll") for (int _i = 0; _i < 2; ++_i) \
        __builtin_amdgcn_global_load_lds((const unsigned*)((const char*)(gbase) + (voff)[_i]), (PG8_LAS unsigned*)(lds + (bufoff) + ldsw + _i * 8192), 16, 0, 0); } while (0)
#define PG8_LDA(dst, b, h) do { _Pragma("unroll") for (int m = 0; m < 4; ++m) _Pragma("unroll") for (int k = 0; k < 2; ++k) dst[m][k] = *(const PG8_LAS bf16x8*)(lds + PG8_SA(b, h) + aoff + m * 2048 + k * 1024); } while (0)
#define PG8_LDB(dst, b, h) do { _Pragma("unroll") for (int n = 0; n < 2; ++n) _Pragma("unroll") for (int k = 0; k < 2; ++k) dst[n][k] = *(const PG8_LAS bf16x8*)(lds + PG8_SB(b, h) + boff + n * 2048 + k * 1024); } while (0)
#define PG8_MMA(ai, bj, At, Bt) do { __builtin_amdgcn_s_setprio(1); _Pragma("unroll") for (int m = 0; m < 4; ++m) _Pragma("unroll") for (int n = 0; n < 2; ++n) _Pragma("unroll") for (int k = 0; k < 2; ++k) \
        acc[ai][bj][m][n] = __builtin_amdgcn_mfma_f32_16x16x32_bf16(Bt[n][k], At[m][k], acc[ai][bj][m][n], 0, 0, 0); __builtin_amdgcn_s_setprio(0); } while (0)
#define PG8_WAIT_V(n) asm volatile("s_waitcnt vmcnt(" #n ")" ::: "memory")
#define PG8_WAIT_L(n) asm volatile("s_waitcnt lgkmcnt(" #n ")" ::: "memory")
#define PG8_BAR __builtin_amdgcn_s_barrier()
#define PG8_SCHED __builtin_amdgcn_sched_barrier(0)
    Unit cur, nxt; int ui = 0;
    if (!S.next(0, cur)) return;
    f32x4 acc[2][2][4][2];
#pragma unroll
    for (int a = 0; a < 2; ++a)
#pragma unroll
        for (int b = 0; b < 2; ++b)
#pragma unroll
            for (int m = 0; m < 4; ++m)
#pragma unroll
                for (int n = 0; n < 2; ++n) acc[a][b][m][n] = (f32x4){0.f, 0.f, 0.f, 0.f};
    bf16x8 At[4][2], B0[2][2], B1[2][2];
    const char* cA = (const char*)g.A + (size_t)cur.pm * tstep; const char* cB = (const char*)g.Bt + (size_t)cur.pn * tstep;
    S.a_ready(cur);
    PG8_STAGE(PG8_SB(0, 0), cB, voffB); PG8_STAGE(PG8_SA(0, 0), cA, voffA); PG8_STAGE(PG8_SB(0, 1), cB + hstep, voffB); PG8_STAGE(PG8_SA(0, 1), cA + hstep, voffA);
    if (wr == 1) PG8_BAR;
    PG8_WAIT_V(4); PG8_BAR;
    PG8_STAGE(PG8_SB(1, 0), cB + kstep, voffB); PG8_STAGE(PG8_SA(1, 0), cA + kstep, voffA); PG8_STAGE(PG8_SB(1, 1), cB + hstep + kstep, voffB);
    PG8_WAIT_V(6); PG8_BAR;
    PG8_STAMP();
    for (;;) {
        const bool has_next = S.next(ui + 1, nxt);
        const char* nA = has_next ? (const char*)g.A + (size_t)nxt.pm * tstep : cA; const char* nB = has_next ? (const char*)g.Bt + (size_t)nxt.pn * tstep : cB;
        for (int t = 0; t < nt; t += 2) {
            const bool last = (t == nt - 2);
            const char* a1 = cA + (size_t)(t + 1) * kstep;
            const char* a2 = last ? nA : cA + (size_t)(t + 2) * kstep; const char* b2 = last ? nB : cB + (size_t)(t + 2) * kstep;
            const char* a3 = a2 + kstep; const char* b3 = b2 + kstep;
            if (last && has_next) S.a_ready(nxt);
            PG8_LDB(B0, 0, 0); PG8_SCHED; PG8_LDA(At, 0, 0); PG8_STAGE(PG8_SA(1, 1), a1 + hstep, voffA);
            PG8_WAIT_L(8); PG8_BAR; PG8_WAIT_L(0); PG8_MMA(0, 0, At, B0); PG8_BAR; PG8_SCHED;
            PG8_LDB(B1, 0, 1); PG8_STAGE(PG8_SB(0, 0), b2, voffB);
            PG8_BAR; PG8_WAIT_L(0); PG8_MMA(0, 1, At, B1); PG8_BAR;
            PG8_LDA(At, 0, 1); PG8_STAGE(PG8_SA(0, 0), a2, voffA);
            PG8_BAR; PG8_WAIT_L(0); PG8_MMA(1, 0, At, B0); PG8_BAR; PG8_SCHED;
            PG8_STAGE(PG8_SB(0, 1), b2 + hstep, voffB);
            PG8_WAIT_V(6); PG8_BAR; PG8_MMA(1, 1, At, B1); PG8_BAR;
            PG8_LDB(B0, 1, 0); PG8_SCHED; PG8_LDA(At, 1, 0); PG8_STAGE(PG8_SA(0, 1), a2 + hstep, voffA);
            PG8_WAIT_L(8); PG8_BAR; PG8_WAIT_L(0); PG8_MMA(0, 0, At, B0); PG8_BAR; PG8_SCHED;
            PG8_LDB(B1, 1, 1); PG8_STAGE(PG8_SB(1, 0), b3, voffB);
            PG8_BAR; PG8_WAIT_L(0); PG8_MMA(0, 1, At, B1); PG8_BAR;
            PG8_LDA(At, 1, 1); PG8_STAGE(PG8_SA(1, 0), a3, voffA);
            PG8_BAR; PG8_WAIT_L(0); PG8_MMA(1, 0, At, B0); PG8_BAR; PG8_SCHED;
            PG8_STAGE(PG8_SB(1, 1), b3 + hstep, voffB);
            PG8_WAIT_V(6); PG8_BAR; PG8_MMA(1, 1, At, B1); PG8_BAR;
        }
        PG8_STAMP();
        if constexpr (!Epi::AFTER_DRAIN) { E(acc, cur, wr, wc, fr, fq); S.done(cur); }
        PG8_STAMP();
        if (!has_next) break;
#pragma unroll
        for (int a = 0; a < 2; ++a)
#pragma unroll
            for (int b = 0; b < 2; ++b)
#pragma unroll
                for (int m = 0; m < 4; ++m)
#pragma unroll
                    for (int n = 0; n < 2; ++n) acc[a][b][m][n] = (f32x4){0.f, 0.f, 0.f, 0.f};
        cur = nxt; cA = nA; cB = nB; ++ui;
    }
    PG8_WAIT_V(0);
    if (wr == 0) PG8_BAR;
    PG8_BAR;
    if constexpr (Epi::AFTER_DRAIN) { E.fused(acc, cur, wr, wc, fr, fq, lds, wid, lane); S.done(cur); }
    PG8_STAMP();
    if (STAMP && wid == 0) { stamps[lane] = lane < nts ? (((unsigned long long)(unsigned)ts_hi << 32) | (unsigned)ts_lo) : 0ull;
        if (lane == 62) stamps[62] = rt_entry; if (lane == 63) stamps[63] = (unsigned long long)wall_clock64(); }
#undef PG8_STAMP
#undef PG8_SA
#undef PG8_SB
#undef PG8_STAGE
#undef PG8_LDA
#undef PG8_LDB
#undef PG8_MMA
#undef PG8_WAIT_V
#undef PG8_WAIT_L
#undef PG8_BAR
#undef PG8_SCHED
}
}

namespace cg = cooperative_groups;
#define LAS __attribute__((address_space(3)))
typedef unsigned short u16;
typedef short bf16x8 __attribute__((ext_vector_type(8)));
typedef float f32x4 __attribute__((ext_vector_type(4)));
typedef unsigned u32x4 __attribute__((ext_vector_type(4)));
typedef unsigned u32x2 __attribute__((ext_vector_type(2)));

constexpr int DM = 1024, NLAT = 32768, NCTX = 2048, MROWS = NLAT + NCTX, NP = 2560, DFF = 4096, NMOD = 6144;
constexpr int NCH = 34;
constexpr float ALPHA_F = 1.189207115002721f;
constexpr float LN_EPS_F = 1e-5f;
constexpr int LDS_BYTES = 144 * 1024;
constexpr int NTHREADS = 512;

constexpr size_t al256(size_t x) { return (x + 255) & ~(size_t)255; }
constexpr size_t WS_BAR = 0;
constexpr size_t WS_WIN = 16384;
constexpr size_t WS_WG = WS_WIN + al256((size_t)NP * DM * 2);
constexpr size_t WS_WOUT = WS_WG + al256((size_t)16 * DM * 2);
constexpr size_t WS_W1 = WS_WOUT + al256((size_t)DM * DM * 2);
constexpr size_t WS_W2 = WS_W1 + al256((size_t)DFF * DM * 2);
constexpr size_t WS_WSB = WS_W2 + al256((size_t)DFF * DM * 2);
constexpr size_t WS_MOD = WS_WSB + al256((size_t)4 * 128 * 128 * 2);
constexpr size_t WS_GATES = WS_MOD + al256((size_t)9 * NMOD * 4);
constexpr size_t WS_GL = WS_GATES + al256((size_t)MROWS * 16 * 4);
constexpr size_t WS_ML = WS_GL + al256((size_t)64 * NCH * 4);
constexpr size_t WS_NU = WS_ML + al256((size_t)64 * NCH * 4);
constexpr size_t WS_NIN = WS_NU + al256((size_t)64 * NCH * 64 * 4);
constexpr size_t WS_MIN = WS_NIN + al256((size_t)64 * 32 * 64 * 4);
constexpr size_t WS_H = WS_MIN + al256((size_t)64 * 32 * 4);
constexpr size_t WS_YCAT = WS_H + al256((size_t)MROWS * DM * 2);
constexpr size_t WS_R1 = WS_YCAT + al256((size_t)NLAT * DM * 2);
constexpr size_t WS_P = WS_R1;
constexpr size_t WS_U = WS_P + al256((size_t)MROWS * NP * 2);
constexpr size_t WS_CIN = WS_U + al256((size_t)64 * NCH * 8192 * 4);
constexpr size_t WS_R1_END = WS_CIN + al256((size_t)64 * 32 * 8192 * 2);
constexpr size_t WS_A = WS_R1;
constexpr size_t WS_END = (WS_R1_END > WS_A + (size_t)NLAT * DFF * 2) ? WS_R1_END : WS_A + (size_t)NLAT * DFF * 2;

struct Params {
    const float *x, *c, *ctx, *c_ctx, *w_ada, *b_ada, *w_in, *w_s, *b_s, *ln_v_g, *ln_v_b, *conv_qk, *b_gates, *hn_g, *w_out, *ln1_g, *ln1_b, *w1, *b1, *w2, *b2, *ln2_g, *ln2_b;
    float* out; unsigned char* ws; int ph_lo, ph_hi;
};

__device__ __forceinline__ float bf2f(u16 b) { return __uint_as_float(((unsigned)b) << 16); }
__device__ __forceinline__ float bflo(unsigned w) { return __uint_as_float(w << 16); }
__device__ __forceinline__ float bfhi(unsigned w) { return __uint_as_float(w & 0xffff0000u); }
__device__ __forceinline__ unsigned pk2(float lo, float hi) { return pg8::cvt_pk_bf16(lo, hi); }
__device__ __forceinline__ u16 f2bf(float x) { return (u16)(pk2(x, 0.f) & 0xffffu); }
__device__ __forceinline__ float wsum(float v) {
#pragma unroll
    for (int o = 32; o >= 1; o >>= 1) v += __shfl_xor(v, o);
    return v; }
__device__ __forceinline__ float wmaxr(float v) {
#pragma unroll
    for (int o = 32; o >= 1; o >>= 1) v = fmaxf(v, __shfl_xor(v, o));
    return v; }
__device__ __forceinline__ float wscan_add(float x, int lane) {
#pragma unroll
    for (int o = 1; o < 64; o <<= 1) { const float y = __shfl_up(x, o); if (lane >= o) x += y; }
    return x; }
__device__ __forceinline__ float wscan_max(float x, int lane) {
#pragma unroll
    for (int o = 1; o < 64; o <<= 1) { const float y = __shfl_up(x, o); if (lane >= o) x = fmaxf(x, y); }
    return x; }
__device__ __forceinline__ float silu_f(float x) { return x / (1.0f + __expf(-x)); }
__device__ __forceinline__ float sigmoid_f(float x) { return 1.0f / (1.0f + __expf(-x)); }
__device__ __forceinline__ float logsigmoid_f(float x) { return fminf(x, 0.f) - log1pf(expf(-fabsf(x))); }

template <int NB, int KS>
__device__ __forceinline__ void wmma_lds(const LAS u16* A, int lda, const LAS u16* B, int ldb, f32x4 (&acc)[NB], int fr, int fq) {
#pragma unroll
    for (int kk = 0; kk < KS; ++kk) {
        const bf16x8 a = *(const LAS bf16x8*)(A + fr * lda + kk * 32 + fq * 8);
#pragma unroll
        for (int nb = 0; nb < NB; ++nb) {
            const bf16x8 b = *(const LAS bf16x8*)(B + (nb * 16 + fr) * ldb + kk * 32 + fq * 8);
            acc[nb] = __builtin_amdgcn_mfma_f32_16x16x32_bf16(a, b, acc[nb], 0, 0, 0);
        }
    }
}

struct TrTile { const float* src; u16* dst; int ld, K; };
__device__ __forceinline__ TrTile tr_decode(const Params& p, int t) {
    constexpr int T_IN = 16 * 40, T_OUT = 16 * 16, T_W1 = 16 * 64;
    unsigned char* ws = p.ws; TrTile r;
    if (t < T_IN) { const int kt = t / 40, nt = t % 40; r.src = p.w_in + (size_t)kt * 64 * 2576 + nt * 64; r.ld = 2576; r.dst = (u16*)(ws + WS_WIN) + (size_t)nt * 64 * 1024 + kt * 64; r.K = 1024; }
    else if (t < T_IN + T_OUT) { const int q = t - T_IN, kt = q / 16, nt = q % 16; r.src = p.w_out + (size_t)kt * 64 * 1024 + nt * 64; r.ld = 1024; r.dst = (u16*)(ws + WS_WOUT) + (size_t)nt * 64 * 1024 + kt * 64; r.K = 1024; }
    else if (t < T_IN + T_OUT + T_W1) { const int q = t - T_IN - T_OUT, kt = q / 64, nt = q % 64; r.src = p.w1 + (size_t)kt * 64 * 4096 + nt * 64; r.ld = 4096; r.dst = (u16*)(ws + WS_W1) + (size_t)nt * 64 * 1024 + kt * 64; r.K = 1024; }
    else { const int q = t - T_IN - T_OUT - T_W1, kt = q / 16, nt = q % 16; r.src = p.w2 + (size_t)kt * 64 * 1024 + nt * 64; r.ld = 1024; r.dst = (u16*)(ws + WS_W2) + (size_t)nt * 64 * 4096 + kt * 64; r.K = 4096; }
    return r;
}
__device__ __forceinline__ void tr_load(const TrTile& T, int tid, f32x4 (&v)[2]) {
    const int r = tid >> 4, c4 = (tid & 15) * 4;
    v[0] = *(const f32x4*)(T.src + (size_t)r * T.ld + c4); v[1] = *(const f32x4*)(T.src + (size_t)(r + 32) * T.ld + c4);
}

__device__ __forceinline__ void phase_prep(const Params& p, LAS unsigned char* lds) {
    const int tid = threadIdx.x, G = gridDim.x, bx = blockIdx.x;
    unsigned char* ws = p.ws;
    {
        LAS float* cs = (LAS float*)lds;
        LAS float* red = (LAS float*)(lds + 9 * 1024 * 4);
        float* mod = (float*)(ws + WS_MOD);
        for (int u = bx; u < NMOD / 32; u += G) {
            for (int i = tid; i < 9 * 1024; i += NTHREADS) { const int r = i >> 10, k = i & 1023; const float v = (r < 8) ? p.c[r * 1024 + k] : p.c_ctx[k]; cs[i] = silu_f(v); }
            __syncthreads();
            const int kg = tid >> 5, col = tid & 31, n0 = u * 32;
            float acc[9];
#pragma unroll
            for (int r = 0; r < 9; ++r) acc[r] = 0.f;
#pragma unroll 16
            for (int k = kg; k < 1024; k += 16) {
                const float w = p.w_ada[(size_t)k * NMOD + n0 + col];
#pragma unroll
                for (int r = 0; r < 9; ++r) acc[r] += cs[r * 1024 + k] * w;
            }
#pragma unroll
            for (int r = 0; r < 9; ++r) red[(kg * 9 + r) * 32 + col] = acc[r];
            __syncthreads();
            if (tid < 288) {
                const int r = tid >> 5, cc = tid & 31; float s = 0.f;
#pragma unroll
                for (int g = 0; g < 16; ++g) s += red[(g * 9 + r) * 32 + cc];
                mod[r * NMOD + n0 + cc] = s + p.b_ada[n0 + cc];
            }
            __syncthreads();
        }
    }
    {
        LAS float* tile = (LAS float*)lds;
        constexpr int T_ALL = 16 * 40 + 16 * 16 + 16 * 64 + 64 * 16;
        int t = bx; f32x4 v[2]; TrTile T;
        if (t < T_ALL) { T = tr_decode(p, t); tr_load(T, tid, v); }
        while (t < T_ALL) {
            {
                const int r = tid >> 4, c4 = (tid & 15) * 4;
#pragma unroll
                for (int hh = 0; hh < 2; ++hh) { LAS float* tp = tile + (r + hh * 32) * 65 + c4; tp[0] = v[hh][0]; tp[1] = v[hh][1]; tp[2] = v[hh][2]; tp[3] = v[hh][3]; }
            }
            __syncthreads();
            const TrTile Tc = T; const int tn = t + G;
            if (tn < T_ALL) { T = tr_decode(p, tn); tr_load(T, tid, v); }
            {
                const int n = tid >> 3, k8 = (tid & 7) * 8; float x[8];
#pragma unroll
                for (int e = 0; e < 8; ++e) x[e] = tile[(k8 + e) * 65 + n];
                u32x4 w; w.x = pk2(x[0], x[1]); w.y = pk2(x[2], x[3]); w.z = pk2(x[4], x[5]); w.w = pk2(x[6], x[7]);
                *(u32x4*)(Tc.dst + (size_t)n * Tc.K + k8) = w;
            }
            __syncthreads();
            t = tn;
        }
    }
    {
        const int gt = bx * NTHREADS + tid, gs = G * NTHREADS;
        u16* wg = (u16*)(ws + WS_WG);
        for (int i = gt; i < 16 * 1024; i += gs) { const int n = i >> 10, k = i & 1023; wg[i] = f2bf(p.w_in[(size_t)k * 2576 + 2560 + n]); }
        u16* wsb = (u16*)(ws + WS_WSB);
        for (int i = gt; i < 4 * 128 * 128; i += gs) wsb[i] = f2bf(p.w_s[i]);
    }
}

__device__ __forceinline__ void row_stats(const f32x4 (&v)[4], float& mu, float& rstd) {
    float s = 0.f;
#pragma unroll
    for (int j = 0; j < 4; ++j) s += (v[j][0] + v[j][1]) + (v[j][2] + v[j][3]);
    mu = wsum(s) * (1.0f / 1024.0f);
    float q = 0.f;
#pragma unroll
    for (int j = 0; j < 4; ++j) { const f32x4 d = v[j] - mu; q += (d[0] * d[0] + d[1] * d[1]) + (d[2] * d[2] + d[3] * d[3]); }
    rstd = rsqrtf(wsum(q) * (1.0f / 1024.0f) + LN_EPS_F);
}

__device__ __forceinline__ const float* ln0_src(const Params& p, int r) { return (r < NLAT) ? p.x + (size_t)r * DM : p.ctx + (size_t)(r - NLAT) * DM; }
__device__ __forceinline__ void phase_ln0(const Params& p) {
    const int lane = threadIdx.x & 63, wave = threadIdx.x >> 6, stride = gridDim.x * 8;
    const float* mod = (const float*)(p.ws + WS_MOD);
    u16* hbuf = (u16*)(p.ws + WS_H);
    int r = blockIdx.x * 8 + wave;
    f32x4 v[4], vn[4];
    if (r < MROWS) { const float* src = ln0_src(p, r);
#pragma unroll
        for (int j = 0; j < 4; ++j) v[j] = *(const f32x4*)(src + j * 256 + lane * 4); }
    while (r < MROWS) {
        const int rn = r + stride;
        if (rn < MROWS) { const float* src = ln0_src(p, rn);
#pragma unroll
            for (int j = 0; j < 4; ++j) vn[j] = *(const f32x4*)(src + j * 256 + lane * 4); }
        const int mb = (r < NLAT) ? (r >> 12) : 8;
        float mu, rstd; row_stats(v, mu, rstd);
        const float* sh = mod + mb * NMOD; const float* sc = sh + 1024;
#pragma unroll
        for (int j = 0; j < 4; ++j) {
            const int col = j * 256 + lane * 4;
            const f32x4 s1 = *(const f32x4*)(sc + col), s0 = *(const f32x4*)(sh + col);
            const f32x4 hv = (v[j] - mu) * rstd * (s1 + 1.0f) + s0;
            u32x2 w; w.x = pk2(hv[0], hv[1]); w.y = pk2(hv[2], hv[3]);
            *(u32x2*)(hbuf + (size_t)r * DM + col) = w;
        }
#pragma unroll
        for (int j = 0; j < 4; ++j) v[j] = vn[j];
        r = rn;
    }
}

__device__ __forceinline__ void phase_ln1(const Params& p) {
    const int lane = threadIdx.x & 63, wave = threadIdx.x >> 6, stride = gridDim.x * 8;
    const float* mod = (const float*)(p.ws + WS_MOD);
    u16* hbuf = (u16*)(p.ws + WS_H);
    int r = blockIdx.x * 8 + wave;
    f32x4 v[4], vn[4];
    if (r < NLAT) {
#pragma unroll
        for (int j = 0; j < 4; ++j) v[j] = *(const f32x4*)(p.out + (size_t)r * DM + j * 256 + lane * 4); }
    while (r < NLAT) {
        const int rn = r + stride;
        if (rn < NLAT) {
#pragma unroll
            for (int j = 0; j < 4; ++j) vn[j] = *(const f32x4*)(p.out + (size_t)rn * DM + j * 256 + lane * 4); }
        float* row = p.out + (size_t)r * DM; const int mb = r >> 12;
        float mu, rstd; row_stats(v, mu, rstd);
#pragma unroll
        for (int j = 0; j < 4; ++j) {
            const int col = j * 256 + lane * 4;
            const f32x4 g = *(const f32x4*)(p.ln1_g + col), b = *(const f32x4*)(p.ln1_b + col);
            v[j] = (v[j] - mu) * rstd * g + b;
            *(f32x4*)(row + col) = v[j];
        }
        row_stats(v, mu, rstd);
        const float* sh = mod + mb * NMOD + 3 * 1024; const float* sc = sh + 1024;
#pragma unroll
        for (int j = 0; j < 4; ++j) {
            const int col = j * 256 + lane * 4;
            const f32x4 s1 = *(const f32x4*)(sc + col), s0 = *(const f32x4*)(sh + col);
            const f32x4 hv = (v[j] - mu) * rstd * (s1 + 1.0f) + s0;
            u32x2 w; w.x = pk2(hv[0], hv[1]); w.y = pk2(hv[2], hv[3]);
            *(u32x2*)(hbuf + (size_t)r * DM + col) = w;
        }
#pragma unroll
        for (int j = 0; j < 4; ++j) v[j] = vn[j];
        r = rn;
    }
}

__device__ __forceinline__ void phase_ln2(const Params& p) {
    const int lane = threadIdx.x & 63, wave = threadIdx.x >> 6, stride = gridDim.x * 8;
    int r = blockIdx.x * 8 + wave;
    f32x4 v[4], vn[4];
    if (r < NLAT) {
#pragma unroll
        for (int j = 0; j < 4; ++j) v[j] = *(const f32x4*)(p.out + (size_t)r * DM + j * 256 + lane * 4); }
    while (r < NLAT) {
        const int rn = r + stride;
        if (rn < NLAT) {
#pragma unroll
            for (int j = 0; j < 4; ++j) vn[j] = *(const f32x4*)(p.out + (size_t)rn * DM + j * 256 + lane * 4); }
        float* row = p.out + (size_t)r * DM;
        float mu, rstd; row_stats(v, mu, rstd);
#pragma unroll
        for (int j = 0; j < 4; ++j) {
            const int col = j * 256 + lane * 4;
            const f32x4 g = *(const f32x4*)(p.ln2_g + col), b = *(const f32x4*)(p.ln2_b + col);
            *(f32x4*)(row + col) = (v[j] - mu) * rstd * g + b;
        }
#pragma unroll
        for (int j = 0; j < 4; ++j) v[j] = vn[j];
        r = rn;
    }
}

__device__ __forceinline__ void gates_unit(const Params& p, int u) {
    const int lane = threadIdx.x & 63, wave = threadIdx.x >> 6, fr = lane & 15, fq = lane >> 4;
    const u16* hbuf = (const u16*)(p.ws + WS_H); const u16* wg = (const u16*)(p.ws + WS_WG);
    float* gates = (float*)(p.ws + WS_GATES);
    const size_t r0 = (size_t)u * 128 + wave * 16;
    const u16* ap = hbuf + (r0 + fr) * DM + fq * 8; const u16* bp = wg + fr * DM + fq * 8;
    f32x4 acc = {0.f, 0.f, 0.f, 0.f};
#pragma unroll 8
    for (int kk = 0; kk < 32; ++kk) {
        const bf16x8 a = *(const bf16x8*)(ap + kk * 32), b = *(const bf16x8*)(bp + kk * 32);
        acc = __builtin_amdgcn_mfma_f32_16x16x32_bf16(a, b, acc, 0, 0, 0);
    }
    const float bg = p.b_gates[fr];
#pragma unroll
    for (int j = 0; j < 4; ++j) gates[(r0 + fq * 4 + j) * 16 + fr] = acc[j] + bg;
}

__device__ __forceinline__ void conv16(const u16* pb, const float* cw, size_t rb, int pos, int seqlen, int col0, int cc0, float (&o)[16]) {
#pragma unroll
    for (int e = 0; e < 16; ++e) o[e] = 0.f;
#pragma unroll
    for (int d = 0; d < 3; ++d) {
        const int pp = pos + d - 1;
        if (pp >= 0 && pp < seqlen) {
            const u16* src = pb + (rb + pp) * NP + col0;
            const u32x4 a = *(const u32x4*)src, b = *(const u32x4*)(src + 8);
            const float* w = cw + d * 512 + cc0;
            const f32x4 w0 = *(const f32x4*)w, w1 = *(const f32x4*)(w + 4), w2 = *(const f32x4*)(w + 8), w3 = *(const f32x4*)(w + 12);
            o[0] += w0[0] * bflo(a.x); o[1] += w0[1] * bfhi(a.x); o[2] += w0[2] * bflo(a.y); o[3] += w0[3] * bfhi(a.y);
            o[4] += w1[0] * bflo(a.z); o[5] += w1[1] * bfhi(a.z); o[6] += w1[2] * bflo(a.w); o[7] += w1[3] * bfhi(a.w);
            o[8] += w2[0] * bflo(b.x); o[9] += w2[1] * bfhi(b.x); o[10] += w2[2] * bflo(b.y); o[11] += w2[3] * bfhi(b.y);
            o[12] += w3[0] * bflo(b.z); o[13] += w3[1] * bfhi(b.z); o[14] += w3[2] * bflo(b.w); o[15] += w3[3] * bfhi(b.w);
        }
    }
#pragma unroll
    for (int e = 0; e < 16; ++e) o[e] = silu_f(o[e]);
}

__device__ __forceinline__ void gmlp_unit(const Params& p, LAS unsigned char* lds, int u) {
    const int tid = threadIdx.x, lane = tid & 63, wave = tid >> 6, fr = lane & 15, fq = lane >> 4;
    const u16* pb = (const u16*)(p.ws + WS_P); const u16* wsb = (const u16*)(p.ws + WS_WSB);
    u16* ycat = (u16*)(p.ws + WS_YCAT);
    const size_t r0 = (size_t)u * 128;
    LAS u16* vT = (LAS u16*)lds;
    LAS float* mus = (LAS float*)(lds + 34816);
    LAS float* rsd = mus + 128;
    for (int i = 0; i < 16; ++i) {
        const int t = wave * 16 + i;
        const u32x4 a = *(const u32x4*)(pb + (r0 + t) * NP + 512 + lane * 8);
        float x[8] = {bflo(a.x), bfhi(a.x), bflo(a.y), bfhi(a.y), bflo(a.z), bfhi(a.z), bflo(a.w), bfhi(a.w)};
        float s = 0.f;
#pragma unroll
        for (int e = 0; e < 8; ++e) s += x[e];
        const float mu = wsum(s) * (1.0f / 512.0f);
        float q = 0.f;
#pragma unroll
        for (int e = 0; e < 8; ++e) { const float d = x[e] - mu; q += d * d; }
        const float rs = rsqrtf(wsum(q) * (1.0f / 512.0f) + LN_EPS_F);
        if (lane == 0) { mus[t] = mu; rsd[t] = rs; }
    }
    for (int g = 0; g < 4; ++g) {
        __syncthreads();
        {
            const int part = tid >> 7, s = tid & 127;
            const float mu = mus[s], rs = rsd[s];
            const u16* src = pb + (r0 + s) * NP + 512 + g * 128 + part * 32;
            const float* gv = p.ln_v_g + g * 128 + part * 32; const float* bv = p.ln_v_b + g * 128 + part * 32;
#pragma unroll
            for (int q4 = 0; q4 < 4; ++q4) {
                const u32x4 a = *(const u32x4*)(src + q4 * 8);
                const float x[8] = {bflo(a.x), bfhi(a.x), bflo(a.y), bfhi(a.y), bflo(a.z), bfhi(a.z), bflo(a.w), bfhi(a.w)};
#pragma unroll
                for (int e = 0; e < 8; ++e) { const int d = q4 * 8 + e; vT[(part * 32 + d) * 136 + s] = f2bf((x[e] - mu) * rs * gv[d] + bv[d]); }
            }
        }
        __syncthreads();
        f32x4 acc[8];
#pragma unroll
        for (int nb = 0; nb < 8; ++nb) acc[nb] = (f32x4){0.f, 0.f, 0.f, 0.f};
        const u16* ap = wsb + (size_t)g * 16384 + (wave * 16 + fr) * 128 + fq * 8;
#pragma unroll
        for (int kk = 0; kk < 4; ++kk) {
            const bf16x8 a = *(const bf16x8*)(ap + kk * 32);
#pragma unroll
            for (int nb = 0; nb < 8; ++nb) {
                const bf16x8 b = *(const LAS bf16x8*)(vT + (nb * 16 + fr) * 136 + kk * 32 + fq * 8);
                acc[nb] = __builtin_amdgcn_mfma_f32_16x16x32_bf16(a, b, acc[nb], 0, 0, 0);
            }
        }
#pragma unroll
        for (int j = 0; j < 4; ++j) {
            const int t = wave * 16 + fq * 4 + j; const float bs = p.b_s[g * 128 + t];
#pragma unroll
            for (int nb = 0; nb < 8; ++nb) {
                const int d = nb * 16 + fr;
                const float uu = bf2f(pb[(r0 + t) * NP + g * 128 + d]);
                ycat[(r0 + t) * DM + g * 128 + d] = f2bf(uu * (acc[nb][j] + bs));
            }
        }
    }
    __syncthreads();
}

__device__ __forceinline__ void state_unit(const Params& p, LAS unsigned char* lds, int u) {
    const int tid = threadIdx.x, lane = tid & 63, wave = tid >> 6, fr = lane & 15, fq = lane >> 4;
    const u16* pb = (const u16*)(p.ws + WS_P);
    const float* gates = (const float*)(p.ws + WS_GATES);
    float* U = (float*)(p.ws + WS_U); float* nU = (float*)(p.ws + WS_NU);
    float* gl = (float*)(p.ws + WS_GL); float* ml = (float*)(p.ws + WS_ML);
    const int c = u % NCH, bh = u / NCH, h = bh & 3, b = bh >> 2;
    size_t rb; int seqlen, cpos;
    if (c < 2) { rb = (size_t)NLAT + b * 256; seqlen = 256; cpos = c; } else { rb = (size_t)b * 4096; seqlen = 4096; cpos = c - 2; }
    const size_t r0 = rb + cpos * 128;
    LAS u16* kwT = (LAS u16*)lds;
    LAS u16* vT = (LAS u16*)(lds + 34816);
    LAS float* wl = (LAS float*)(lds + 69632);
    if (wave < 2) {
        const int dir = wave;
        const int j0 = dir ? 127 - 2 * lane : 2 * lane, j1 = dir ? 126 - 2 * lane : 2 * lane + 1;
        const float gi0 = gates[(r0 + j0) * 16 + dir * 8 + h], gf0 = gates[(r0 + j0) * 16 + dir * 8 + 4 + h];
        const float gi1 = gates[(r0 + j1) * 16 + dir * 8 + h], gf1 = gates[(r0 + j1) * 16 + dir * 8 + 4 + h];
        const float lf0 = logsigmoid_f(gf0), lf1 = logsigmoid_f(gf1);
        const float incl = wscan_add(lf0 + lf1, lane);
        const float b0 = incl - lf1, b1 = incl;
        const float tot = __shfl(incl, 63);
        const float d0 = tot - b0 + gi0, d1 = tot - b1 + gi1;
        const float mloc = wmaxr(fmaxf(d0, d1));
        wl[dir * 128 + j0] = __expf(d0 - mloc); wl[dir * 128 + j1] = __expf(d1 - mloc);
        if (lane == 0) { const int scan = bh * 2 + dir; gl[scan * NCH + c] = tot; ml[scan * NCH + c] = mloc; }
    }
    __syncthreads();
    {
        const int part = tid >> 7, j = tid & 127;
        float kc[16];
        conv16(pb, p.conv_qk, rb, cpos * 128 + j, seqlen, 1280 + h * 64 + part * 16, 256 + h * 64 + part * 16, kc);
        const float wf = wl[j], wb = wl[128 + j];
#pragma unroll
        for (int e = 0; e < 16; ++e) { kwT[(part * 16 + e) * 136 + j] = f2bf(wf * kc[e]); kwT[(64 + part * 16 + e) * 136 + j] = f2bf(wb * kc[e]); }
        const u16* src = pb + (r0 + j) * NP + 1536 + h * 128 + part * 32;
#pragma unroll
        for (int q4 = 0; q4 < 4; ++q4) {
            const u32x4 a = *(const u32x4*)(src + q4 * 8);
            const unsigned wv[4] = {a.x, a.y, a.z, a.w};
#pragma unroll
            for (int e = 0; e < 4; ++e) { vT[(part * 32 + q4 * 8 + 2 * e) * 136 + j] = (u16)(wv[e] & 0xffffu); vT[(part * 32 + q4 * 8 + 2 * e + 1) * 136 + j] = (u16)(wv[e] >> 16); }
        }
    }
    __syncthreads();
    f32x4 acc[8];
#pragma unroll
    for (int nb = 0; nb < 8; ++nb) acc[nb] = (f32x4){0.f, 0.f, 0.f, 0.f};
    wmma_lds<8, 4>(vT + wave * 16 * 136, 136, kwT, 136, acc, fr, fq);
#pragma unroll
    for (int nb = 0; nb < 8; ++nb) {
        const int dir = nb >> 2, kk = (nb & 3) * 16 + fr, scan = bh * 2 + dir;
#pragma unroll
        for (int j = 0; j < 4; ++j) { const int vv = wave * 16 + fq * 4 + j; U[(((size_t)scan * NCH + c) * 128 + vv) * 64 + kk] = acc[nb][j]; }
    }
    if (tid < 128) {
        const int dir = tid >> 6, kk = tid & 63, scan = bh * 2 + dir; float s = 0.f;
        for (int j = 0; j < 128; ++j) s += bf2f(kwT[tid * 136 + j]);
        nU[((size_t)scan * NCH + c) * 64 + kk] = s;
    }
    __syncthreads();
}

__device__ __forceinline__ int scan_chunk(int dir, int step) { return dir ? (step < 2 ? 1 - step : 35 - step) : step; }
__device__ __forceinline__ void phase_scan(const Params& p) {
    const float* U = (const float*)(p.ws + WS_U); const float* nU = (const float*)(p.ws + WS_NU);
    const float* gl = (const float*)(p.ws + WS_GL); const float* ml = (const float*)(p.ws + WS_ML);
    u16* cin = (u16*)(p.ws + WS_CIN); float* nin = (float*)(p.ws + WS_NIN); float* min_ = (float*)(p.ws + WS_MIN);
    const int gs = gridDim.x * NTHREADS;
    constexpr int PD = 6;
    for (int item = blockIdx.x * NTHREADS + threadIdx.x; item < 64 * 2048; item += gs) {
        const int scan = item >> 11, q = item & 2047, dir = scan & 1;
        f32x4 C = {0.f, 0.f, 0.f, 0.f}, n = {0.f, 0.f, 0.f, 0.f}; float m = 0.f;
        const bool hasn = q < 16;
        const float* Ub = U + (size_t)scan * NCH * 8192 + q * 4;
        const float* nb = nU + (size_t)scan * NCH * 64 + (q & 15) * 4;
        f32x4 Ur[PD], nr[PD]; float gr[PD], mr[PD];
#pragma unroll
        for (int i = 0; i < PD; ++i) { const int c = scan_chunk(dir, i); Ur[i] = *(const f32x4*)(Ub + (size_t)c * 8192); nr[i] = *(const f32x4*)(nb + c * 64); gr[i] = gl[scan * NCH + c]; mr[i] = ml[scan * NCH + c]; }
#pragma unroll
        for (int step = 0; step < NCH; ++step) {
            const int sl = step % PD;
            const f32x4 Uc = Ur[sl], nc = nr[sl]; const float g = gr[sl], mlc = mr[sl];
            const int cc = scan_chunk(dir, step);
            if (step + PD < NCH) { const int c = scan_chunk(dir, step + PD); Ur[sl] = *(const f32x4*)(Ub + (size_t)c * 8192); nr[sl] = *(const f32x4*)(nb + c * 64); gr[sl] = gl[scan * NCH + c]; mr[sl] = ml[scan * NCH + c]; }
            if (step >= 2) {
                const int cl = cc - 2;
                u32x2 w; w.x = pk2(C[0], C[1]); w.y = pk2(C[2], C[3]);
                *(u32x2*)(cin + (((size_t)scan * 32 + cl) * 2048 + q) * 4) = w;
                if (hasn) *(f32x4*)(nin + ((size_t)scan * 32 + cl) * 64 + q * 4) = n;
                if (q == 0) min_[scan * 32 + cl] = m;
            }
            const float mn = fmaxf(g + m, mlc), aa = __expf(g + m - mn), ss = __expf(mlc - mn);
            C = C * aa + Uc * ss; n = n * aa + nc * ss; m = mn;
        }
    }
}

__device__ __forceinline__ void out_unit(const Params& p, LAS unsigned char* lds, int u) {
    const int tid = threadIdx.x, lane = tid & 63, wave = tid >> 6, fr = lane & 15, fq = lane >> 4;
    const u16* pb = (const u16*)(p.ws + WS_P);
    const float* gates = (const float*)(p.ws + WS_GATES);
    const u16* cin = (const u16*)(p.ws + WS_CIN); const float* nin = (const float*)(p.ws + WS_NIN); const float* min_ = (const float*)(p.ws + WS_MIN);
    u16* ycat = (u16*)(p.ws + WS_YCAT);
    const int n = u & 31, bh = u >> 5, h = bh & 3, b = bh >> 2;
    const size_t rb = (size_t)b * 4096, r0 = rb + n * 128;
    LAS u16* qs = (LAS u16*)lds;
    LAS u16* ks = (LAS u16*)(lds + 18432);
    LAS u16* vT = (LAS u16*)(lds + 36864);
    LAS u16* cT = (LAS u16*)(lds + 76032);
    LAS u16* sp = (LAS u16*)(lds + 96768);
    LAS float* aA = (LAS float*)(lds + 131584);
    LAS float* MM = aA + 256;
    LAS float* BB = MM + 256;
    LAS float* m0s = BB + 256;
    if (wave < 2) {
        const int dir = wave, scan = bh * 2 + dir;
        const float m0 = min_[scan * 32 + n];
        const int j0 = dir ? 127 - 2 * lane : 2 * lane, j1 = dir ? 126 - 2 * lane : 2 * lane + 1;
        const float gi0 = gates[(r0 + j0) * 16 + dir * 8 + h], gf0 = gates[(r0 + j0) * 16 + dir * 8 + 4 + h];
        const float gi1 = gates[(r0 + j1) * 16 + dir * 8 + h], gf1 = gates[(r0 + j1) * 16 + dir * 8 + 4 + h];
        const float lf0 = logsigmoid_f(gf0), lf1 = logsigmoid_f(gf1);
        const float incl = wscan_add(lf0 + lf1, lane);
        const float b0 = incl - lf1, b1 = incl;
        const float a0 = gi0 - b0, a1 = gi1 - b1;
        const float im = wscan_max(fmaxf(a0, a1), lane);
        float ex = __shfl_up(im, 1); if (lane == 0) ex = -INFINITY;
        const float M0 = fmaxf(m0, fmaxf(ex, a0)), M1 = fmaxf(m0, im);
        aA[dir * 128 + j0] = a0; aA[dir * 128 + j1] = a1;
        MM[dir * 128 + j0] = M0; MM[dir * 128 + j1] = M1;
        BB[dir * 128 + j0] = b0; BB[dir * 128 + j1] = b1;
        if (lane == 0) m0s[dir] = m0;
    }
    {
        const int part = tid >> 7, j = tid & 127;
        float t16[16];
        conv16(pb, p.conv_qk, rb, n * 128 + j, 4096, 1024 + h * 64 + part * 16, h * 64 + part * 16, t16);
        {
            u32x4 w0, w1;
            w0.x = pk2(t16[0] * 0.125f, t16[1] * 0.125f); w0.y = pk2(t16[2] * 0.125f, t16[3] * 0.125f); w0.z = pk2(t16[4] * 0.125f, t16[5] * 0.125f); w0.w = pk2(t16[6] * 0.125f, t16[7] * 0.125f);
            w1.x = pk2(t16[8] * 0.125f, t16[9] * 0.125f); w1.y = pk2(t16[10] * 0.125f, t16[11] * 0.125f); w1.z = pk2(t16[12] * 0.125f, t16[13] * 0.125f); w1.w = pk2(t16[14] * 0.125f, t16[15] * 0.125f);
            *(LAS u32x4*)(qs + j * 72 + part * 16) = w0; *(LAS u32x4*)(qs + j * 72 + part * 16 + 8) = w1;
        }
        conv16(pb, p.conv_qk, rb, n * 128 + j, 4096, 1280 + h * 64 + part * 16, 256 + h * 64 + part * 16, t16);
        {
            u32x4 w0, w1;
            w0.x = pk2(t16[0], t16[1]); w0.y = pk2(t16[2], t16[3]); w0.z = pk2(t16[4], t16[5]); w0.w = pk2(t16[6], t16[7]);
            w1.x = pk2(t16[8], t16[9]); w1.y = pk2(t16[10], t16[11]); w1.z = pk2(t16[12], t16[13]); w1.w = pk2(t16[14], t16[15]);
            *(LAS u32x4*)(ks + j * 72 + part * 16) = w0; *(LAS u32x4*)(ks + j * 72 + part * 16 + 8) = w1;
        }
        const u16* src = pb + (r0 + j) * NP + 1536 + h * 128 + part * 32;
#pragma unroll
        for (int q4 = 0; q4 < 4; ++q4) {
            const u32x4 a = *(const u32x4*)(src + q4 * 8);
            const unsigned wv[4] = {a.x, a.y, a.z, a.w};
#pragma unroll
            for (int e = 0; e < 4; ++e) { vT[(part * 32 + q4 * 8 + 2 * e) * 136 + j] = (u16)(wv[e] & 0xffffu); vT[(part * 32 + q4 * 8 + 2 * e + 1) * 136 + j] = (u16)(wv[e] >> 16); }
        }
        if (tid < 128) vT[128 * 136 + tid] = (u16)0x3F80u;
        for (int i = tid; i < 15 * 136; i += NTHREADS) vT[129 * 136 + i] = (u16)0;
        for (int i = tid; i < 15 * 72; i += NTHREADS) cT[129 * 72 + i] = (u16)0;
    }
    f32x4 hs[8];
#pragma unroll
    for (int nb = 0; nb < 8; ++nb) hs[nb] = (f32x4){0.f, 0.f, 0.f, 0.f};
    for (int dir = 0; dir < 2; ++dir) {
        const int scan = bh * 2 + dir;
        {
            const int vv = tid >> 2, seg = (tid & 3) * 16;
            const u16* src = cin + (((size_t)scan * 32 + n) * 128 + vv) * 64 + seg;
            const u32x4 a = *(const u32x4*)src, bq = *(const u32x4*)(src + 8);
            *(LAS u32x4*)(cT + vv * 72 + seg) = a; *(LAS u32x4*)(cT + vv * 72 + seg + 8) = bq;
            if (tid < 64) cT[128 * 72 + tid] = f2bf(nin[((size_t)scan * 32 + n) * 64 + tid]);
        }
        __syncthreads();
        f32x4 accs[8];
#pragma unroll
        for (int nb = 0; nb < 8; ++nb) accs[nb] = (f32x4){0.f, 0.f, 0.f, 0.f};
        wmma_lds<8, 2>(qs + wave * 16 * 72, 72, ks, 72, accs, fr, fq);
#pragma unroll
        for (int j = 0; j < 4; ++j) {
            const int t = wave * 16 + fq * 4 + j; const float Mt = MM[dir * 128 + t];
#pragma unroll
            for (int nb = 0; nb < 8; ++nb) {
                const int s = nb * 16 + fr;
                const bool valid = dir ? (s >= t) : (s <= t);
                const float val = valid ? accs[nb][j] * __expf(aA[dir * 128 + s] - Mt) : 0.f;
                sp[(wave * 16 + fq * 4 + j) * 136 + s] = f2bf(val);
            }
        }
        __syncthreads();
        f32x4 accn[9];
#pragma unroll
        for (int nb = 0; nb < 9; ++nb) accn[nb] = (f32x4){0.f, 0.f, 0.f, 0.f};
        wmma_lds<9, 4>(sp + wave * 16 * 136, 136, vT, 136, accn, fr, fq);
        {
            const float sc = __expf(m0s[dir] - MM[dir * 128 + wave * 16 + fr]);
#pragma unroll
            for (int kk = 0; kk < 2; ++kk) {
                const u32x4 qa = *(const LAS u32x4*)(qs + (wave * 16 + fr) * 72 + kk * 32 + fq * 8);
                u32x4 qb;
                qb.x = pk2(bflo(qa.x) * sc, bfhi(qa.x) * sc); qb.y = pk2(bflo(qa.y) * sc, bfhi(qa.y) * sc);
                qb.z = pk2(bflo(qa.z) * sc, bfhi(qa.z) * sc); qb.w = pk2(bflo(qa.w) * sc, bfhi(qa.w) * sc);
                const bf16x8 a = __builtin_bit_cast(bf16x8, qb);
#pragma unroll
                for (int nb = 0; nb < 9; ++nb) {
                    const bf16x8 bb = *(const LAS bf16x8*)(cT + (nb * 16 + fr) * 72 + kk * 32 + fq * 8);
                    accn[nb] = __builtin_amdgcn_mfma_f32_16x16x32_bf16(a, bb, accn[nb], 0, 0, 0);
                }
            }
        }
#pragma unroll
        for (int j = 0; j < 4; ++j) {
            const int t = wave * 16 + fq * 4 + j;
            const float den = __shfl(accn[8][j], lane & 48);
            const float lim = __expf(-(BB[dir * 128 + t] + MM[dir * 128 + t]));
            const float inv = 1.0f / fmaxf(fabsf(den), lim);
#pragma unroll
            for (int nb = 0; nb < 8; ++nb) hs[nb][j] += accn[nb][j] * inv;
        }
        __syncthreads();
    }
#pragma unroll
    for (int j = 0; j < 4; ++j) {
        const int t = wave * 16 + fq * 4 + j;
        float s = 0.f;
#pragma unroll
        for (int nb = 0; nb < 8; ++nb) s += hs[nb][j];
        s += __shfl_xor(s, 1); s += __shfl_xor(s, 2); s += __shfl_xor(s, 4); s += __shfl_xor(s, 8);
        const float mu = s * (1.0f / 128.0f);
        float q = 0.f;
#pragma unroll
        for (int nb = 0; nb < 8; ++nb) { const float d = hs[nb][j] - mu; q += d * d; }
        q += __shfl_xor(q, 1); q += __shfl_xor(q, 2); q += __shfl_xor(q, 4); q += __shfl_xor(q, 8);
        const float rs = rsqrtf(q * (1.0f / 128.0f) + LN_EPS_F);
#pragma unroll
        for (int nb = 0; nb < 8; ++nb) {
            const int vv = nb * 16 + fr;
            const float o = bf2f(pb[(r0 + t) * NP + 2048 + h * 128 + vv]);
            const float y = (hs[nb][j] - mu) * rs * p.hn_g[h * 128 + vv] * sigmoid_f(o);
            ycat[(r0 + t) * DM + 512 + h * 128 + vv] = f2bf(y);
        }
    }
}

struct EpiResid {
    static constexpr bool PERM = false, AFTER_DRAIN = false;
    const float* src; float* out; const float* gate; const float* bias;
    __device__ __forceinline__ void operator()(const pg8::f32x4 (&acc)[2][2][4][2], const pg8::Unit& u, int wr, int wc, int fr, int fq) const {
        const int row0 = u.pm * 256 + wr * 64 + fr, col0 = u.pn * 256 + wc * 32 + 4 * fq;
        const float* gp = gate + (size_t)(u.pm >> 4) * NMOD;
#pragma unroll
        for (int bj = 0; bj < 2; ++bj)
#pragma unroll
            for (int n = 0; n < 2; ++n) {
                const int cidx = col0 + bj * 128 + n * 16;
                const f32x4 gv = *(const f32x4*)(gp + cidx);
                const f32x4 bv = bias ? *(const f32x4*)(bias + cidx) : (f32x4){0.f, 0.f, 0.f, 0.f};
#pragma unroll
                for (int ai = 0; ai < 2; ++ai)
#pragma unroll
                    for (int m = 0; m < 4; ++m) {
                        const size_t off = (size_t)(row0 + ai * 128 + m * 16) * DM + cidx;
                        const f32x4 xs = *(const f32x4*)(src + off);
                        *(f32x4*)(out + off) = xs * ALPHA_F + gv * (acc[ai][bj][m][n] + bv);
                    }
            }
    }
};

#define XB_TMO      128
#define XB_XCNT(j)  (256  + 64 * (j))
#define XB_XSUB(j)  (1280 + 64 * (j))
#define XB_XGEN(j)  (2304 + 64 * (j))
#define XB_TOP      3328
#define XB_TOPGEN   3392
#define XCD_BAR_WORDS 3456
#define XB_SPIN_CAP (1u << 18)

__device__ __forceinline__ unsigned xb_ld(unsigned* p)              { return __hip_atomic_load(p, __ATOMIC_RELAXED, __HIP_MEMORY_SCOPE_AGENT); }
__device__ __forceinline__ unsigned xb_add(unsigned* p, unsigned v) { return __hip_atomic_fetch_add(p, v, __ATOMIC_RELAXED, __HIP_MEMORY_SCOPE_AGENT); }
__device__ __forceinline__ unsigned xb_xcc_id() { return (unsigned)__builtin_amdgcn_s_getreg((3 << 11) | 20) & 0xFu; }
#define XB_SPIN(cond, bar) do { unsigned _sp = 0; while (cond) { __builtin_amdgcn_s_sleep(1); \
    if ((++_sp & 255u) == 0u) { if (xb_ld(&(bar)[XB_TMO])) break; if (_sp > XB_SPIN_CAP) { atomicAdd(&(bar)[XB_TMO], 1u); break; } } } } while (0)

struct XcdBarrier {
    unsigned* bar; unsigned x;
    volatile LAS unsigned* st;
};

__device__ __forceinline__ XcdBarrier xcd_barrier_post(unsigned* bar, volatile LAS unsigned* st) {
    XcdBarrier b; b.bar = bar; b.x = xb_xcc_id(); b.st = st;
    if (threadIdx.x == 0) (void)xb_add(&bar[XB_XCNT(b.x)], 1u);
    return b;
}
__device__ __forceinline__ void xcd_barrier_complete(unsigned* bar, unsigned x, unsigned& nloc, unsigned& nx) {
    const unsigned G = gridDim.x * gridDim.y * gridDim.z;
    unsigned sum, cnt, mine, sp = 0u;
    for (;;) {
        sum = 0u; cnt = 0u; mine = 0u;
#pragma unroll
        for (unsigned j = 0; j < 16; ++j) { const unsigned c = xb_ld(&bar[XB_XCNT(j)]); sum += c; cnt += (c > 0u) ? 1u : 0u; mine = (j == x) ? c : mine; }
        if (sum == G) break;
        __builtin_amdgcn_s_sleep(1);
        if ((++sp & 255u) == 0u) { if (xb_ld(&bar[XB_TMO])) break; if (sp > XB_SPIN_CAP) { atomicAdd(&bar[XB_TMO], 1u); break; } }
    }
    nloc = mine > 0u ? mine : 1u; nx = cnt > 0u ? cnt : 1u;
}

__device__ __forceinline__ void xcd_barrier(const XcdBarrier& b) {
    asm volatile("s_waitcnt vmcnt(0)" ::: "memory");
    __syncthreads();
    if (threadIdx.x == 0) {
        unsigned* bar = b.bar;
        __builtin_amdgcn_s_waitcnt(0);
        unsigned nloc = b.st[0], nx = b.st[1];
        if (nloc == 0u) { xcd_barrier_complete(bar, b.x, nloc, nx); b.st[0] = nloc; b.st[1] = nx; }
        const unsigned old = xb_add(&bar[XB_XSUB(b.x)], 1u);
        const unsigned gen = old / nloc;
        if (old + 1u == (gen + 1u) * nloc) {
            __builtin_amdgcn_fence(__ATOMIC_RELEASE, "agent");
            asm volatile("s_waitcnt vmcnt(0)" ::: "memory");
            const unsigned og = xb_add(&bar[XB_TOP], 1u);
            const unsigned tg = og / nx;
            if (og + 1u == (tg + 1u) * nx) xb_add(&bar[XB_TOPGEN], 1u);
            else XB_SPIN(xb_ld(&bar[XB_TOPGEN]) == tg, bar);
            __builtin_amdgcn_fence(__ATOMIC_ACQUIRE, "agent");
            xb_add(&bar[XB_XGEN(b.x)], 1u);
            asm volatile("s_waitcnt vmcnt(0)" ::: "memory");
        } else {
            XB_SPIN(xb_ld(&bar[XB_XGEN(b.x)]) == gen, bar);
            __builtin_amdgcn_fence(__ATOMIC_ACQUIRE, "agent");
            asm volatile("s_waitcnt vmcnt(0)" ::: "memory");
        }
    }
    __syncthreads();
}


#ifndef PH_MASK
#define PH_MASK 0x7FF
#endif
#define PHM(k) (((PH_MASK) >> (k)) & 1)
__global__ void __launch_bounds__(NTHREADS, 2) mega(Params p) {
    extern __shared__ __attribute__((aligned(16))) unsigned char smem[];
    LAS unsigned char* lds = (LAS unsigned char*)smem;
    cg::grid_group grid = cg::this_grid();
    const int G = gridDim.x, bx = blockIdx.x;
    unsigned char* ws = p.ws;
    const int lo = p.ph_lo, hi = p.ph_hi;
    volatile LAS unsigned* xst = (volatile LAS unsigned*)(lds + LDS_BYTES - 16);
    if (threadIdx.x < 4) xst[threadIdx.x] = 0u;
    __syncthreads();
    XcdBarrier xbar = xcd_barrier_post((unsigned*)(ws + WS_BAR), xst);
#define IN(k) (PHM(k) && lo <= (k) && (k) <= hi)
#define SEAM(k) do { if ((k) < hi) { if ((k) == 0) grid.sync(); else xcd_barrier(xbar); } } while (0)
    if (IN(0)) { phase_prep(p, lds); SEAM(0); }
    if (IN(1)) { phase_ln0(p); SEAM(1); }
    if (IN(2)) {
            pg8::Gemm g{(const pg8::bf16_t*)(ws + WS_H), (const pg8::bf16_t*)(ws + WS_WIN), MROWS, NP, DM};
            pg8::StaticOrder S; S.init(MROWS, NP, G, bx);
            pg8::EpiBf16<0> E{(pg8::bf16_t*)(ws + WS_P), NP, nullptr, 0, 0};
            pg8::gemm_phase<pg8::EpiBf16<0>, pg8::StaticOrder, false>(lds, g, S, E, nullptr);
            for (int u = G - 1 - bx; u < MROWS / 128; u += G) gates_unit(p, u);
        SEAM(2);
    }
    if (IN(3)) {
            for (int u = bx; u < 1088 + 256; u += G) { if (u < 1088) state_unit(p, lds, u); else gmlp_unit(p, lds, u - 1088); }
        SEAM(3);
    }
    if (IN(4)) { phase_scan(p); SEAM(4); }
    if (IN(5)) { for (int u = bx; u < 1024; u += G) out_unit(p, lds, u); SEAM(5); }
    if (IN(6)) {
            pg8::Gemm g{(const pg8::bf16_t*)(ws + WS_YCAT), (const pg8::bf16_t*)(ws + WS_WOUT), NLAT, DM, DM};
            pg8::StaticOrder S; S.init(NLAT, DM, G, bx);
            EpiResid E{p.x, p.out, (const float*)(ws + WS_MOD) + 2 * 1024, nullptr};
            pg8::gemm_phase<EpiResid, pg8::StaticOrder, false>(lds, g, S, E, nullptr);
        SEAM(6);
    }
    if (IN(7)) { phase_ln1(p); SEAM(7); }
    if (IN(8)) {
            pg8::Gemm g{(const pg8::bf16_t*)(ws + WS_H), (const pg8::bf16_t*)(ws + WS_W1), NLAT, DFF, DM};
            pg8::StaticOrder S; S.init(NLAT, DFF, G, bx);
            pg8::EpiBf16<3> E{(pg8::bf16_t*)(ws + WS_A), DFF, p.b1, 0, 0};
            pg8::gemm_phase<pg8::EpiBf16<3>, pg8::StaticOrder, false>(lds, g, S, E, nullptr);
        SEAM(8);
    }
    if (IN(9)) {
            pg8::Gemm g{(const pg8::bf16_t*)(ws + WS_A), (const pg8::bf16_t*)(ws + WS_W2), NLAT, DM, DFF};
            pg8::StaticOrder S; S.init(NLAT, DM, G, bx);
            EpiResid E{p.out, p.out, (const float*)(ws + WS_MOD) + 5 * 1024, p.b2};
            pg8::gemm_phase<EpiResid, pg8::StaticOrder, false>(lds, g, S, E, nullptr);
        SEAM(9);
    }
    if (IN(10)) { phase_ln2(p); }
#undef IN
#undef SEAM
}

constexpr int NPHASES = 11;
#ifndef N_LAUNCH_MODE
#define N_LAUNCH_MODE 0
#endif

extern "C" void kernel_launch(void* const* d_in, const int* in_sizes, int n_in, void* d_out, int out_size, void* d_ws, size_t ws_size, hipStream_t stream) {
    static int grid = 0;
    if (grid == 0) {
        if (n_in != 23 || ws_size < WS_END) { fprintf(stderr, "kernel_launch: unexpected n_in %d or ws_size %zu (< %zu)\n", n_in, ws_size, (size_t)WS_END); grid = -1; return; }
        int dev = 0, cus = 0, per_cu = 0;
        hipGetDevice(&dev);
        hipDeviceGetAttribute(&cus, hipDeviceAttributeMultiprocessorCount, dev);
        if (hipFuncSetAttribute((const void*)mega, hipFuncAttributeMaxDynamicSharedMemorySize, LDS_BYTES) != hipSuccess) { fprintf(stderr, "kernel_launch: hipFuncSetAttribute failed\n"); grid = -1; return; }
        if (hipOccupancyMaxActiveBlocksPerMultiprocessor(&per_cu, (const void*)mega, NTHREADS, LDS_BYTES) != hipSuccess || per_cu < 1) { fprintf(stderr, "kernel_launch: occupancy query says %d\n", per_cu); per_cu = 1; (void)hipGetLastError(); }
        if (per_cu > 1) per_cu = 1;
        grid = cus * per_cu;
    }
    if (grid < 0) return;
    if (hipMemsetAsync(d_ws, 0, XCD_BAR_WORDS * 4, stream) != hipSuccess) { fprintf(stderr, "kernel_launch: memset failed\n"); return; }
    Params p{};
    const float** pf = (const float**)&p;
    for (int i = 0; i < 23; ++i) pf[i] = (const float*)d_in[i];
    p.out = (float*)d_out; p.ws = (unsigned char*)d_ws;
#if N_LAUNCH_MODE == 1
#ifndef REPEAT_PHASE
#define REPEAT_PHASE -1
#endif
    for (int ph = 0; ph < NPHASES; ++ph) { p.ph_lo = ph; p.ph_hi = ph; const int reps = (ph == REPEAT_PHASE) ? 3 : 1;
        for (int r = 0; r < reps; ++r) hipLaunchKernelGGL(mega, dim3(grid), dim3(NTHREADS), LDS_BYTES, stream, p); }
#else
    p.ph_lo = 0; p.ph_hi = NPHASES - 1;
    void* args[] = {&p};
    hipError_t e = hipLaunchCooperativeKernel((const void*)mega, dim3(grid), dim3(NTHREADS), args, LDS_BYTES, stream);
    if (e != hipSuccess) fprintf(stderr, "cooperative launch failed: %s (grid %d)\n", hipGetErrorString(e), grid);
#endif
}
```
